# Optimizing an MI355X kernel written in HIP

```python
import math
import jax
import jax.numpy as jnp
from jax import lax
import numpy as np

D_MODEL = 1024
BATCH = 8
SEQ = 2048
DEPTH = 2

CTX_LEN = 256
GRID_W = 64
HEAD_DIM = 64
Q_BLOCK = 128
MIX_HALF = D_MODEL // 2
A_HEADS = MIX_HALF // HEAD_DIM
A_KV_HEADS = max(1, A_HEADS // 4)
A_GROUP = A_HEADS // A_KV_HEADS
B_HEADS = MIX_HALF // (2 * HEAD_DIM)
B_V_DIM = 2 * HEAD_DIM
C_HEADS = MIX_HALF // HEAD_DIM
WIN_H = 8
WIN_W = 16
D_GROUPS = 4
D_GROUP_DIM = MIX_HALF // D_GROUPS
FFN_DIM = 4 * D_MODEL
ROPE_THETA = 10000.0
N_EVEN = (DEPTH + 1) // 2
N_ODD = DEPTH // 2
ALPHA = (2.0 * DEPTH) ** 0.25
BETA = (8.0 * DEPTH) ** -0.25
EPS = 1e-6
ATTN_SCALE = HEAD_DIM ** -0.5
QA_W = A_HEADS * HEAD_DIM
QB_W = B_HEADS * 2 * HEAD_DIM
KA_W = A_KV_HEADS * HEAD_DIM
VA_W = KA_W
KB_W = QB_W
VB_W = B_HEADS * B_V_DIM
AB_Q_W = QA_W + QB_W
AB_IN_W = AB_Q_W + KA_W + VA_W + KB_W + VB_W
AB_OUT_IN = QA_W + VB_W
C_W = C_HEADS * HEAD_DIM
CD_Q_W = C_W + MIX_HALF
CD_IN_W = CD_Q_W + 2 * C_W
CD_OUT_IN = C_W + MIX_HALF

kernel_name = 'hybrid_gqa_diff_natten_fnet_prefix_dit'


def _rms_norm(x, g):
    xf = x.astype(jnp.float32)
    y = xf * lax.rsqrt(jnp.mean(xf * xf, axis=-1, keepdims=True) + EPS)
    return (y * g.astype(jnp.float32)).astype(x.dtype)


def _layer_norm(x, g, b):
    xf = x.astype(jnp.float32)
    mu = jnp.mean(xf, axis=-1, keepdims=True)
    xc = xf - mu
    var = jnp.mean(xc * xc, axis=-1, keepdims=True)
    return (xc * lax.rsqrt(var + EPS) * g.astype(jnp.float32) + b.astype(jnp.float32)).astype(x.dtype)


def _axial_rope_tables(n, dtype):
    pos = jnp.arange(n)
    row = (pos // GRID_W).astype(jnp.float32)
    col = (pos % GRID_W).astype(jnp.float32)
    half = HEAD_DIM // 2
    freqs = jnp.power(ROPE_THETA, -jnp.arange(0, half, 2, dtype=jnp.float32) / half)
    def axis_angles(p):
        a = p[:, None] * freqs[None, :]
        return jnp.concatenate([a, a], axis=-1)
    ang = jnp.concatenate([axis_angles(row), axis_angles(col)], axis=-1)
    return jnp.cos(ang).astype(dtype), jnp.sin(ang).astype(dtype)


def _rotate_axial(x):
    xa = x.reshape(x.shape[:-1] + (2, 2, HEAD_DIM // 4))
    return jnp.concatenate([-xa[..., 1:, :], xa[..., :1, :]], axis=-2).reshape(x.shape)


def _apply_rope(x, cos, sin):
    shp = (x.shape[1],) + (1,) * (x.ndim - 3) + (x.shape[-1],)
    return x * cos.reshape(shp) + _rotate_axial(x) * sin.reshape(shp)


def _sweep(q, fn):
    b, n = q.shape[:2]
    nb = n // Q_BLOCK
    qb = jnp.moveaxis(q.reshape((b, nb, Q_BLOCK) + q.shape[2:]), 1, 0)
    out = lax.map(fn, qb)
    return jnp.moveaxis(out, 0, 1).reshape((b, n) + out.shape[3:])


def _gqa_core(q, k, v):
    s = jnp.einsum('bqkgd,bmkd->bkgqm', q, k).astype(jnp.float32) * ATTN_SCALE
    p = jax.nn.softmax(s, axis=-1).astype(v.dtype)
    o = jnp.einsum('bkgqm,bmkd->bqkgd', p, v)
    return o.reshape(o.shape[:2] + (-1,))


def _diff_core(q, k, v, lam, lam_init, subln):
    s = jnp.einsum('bqhjd,bmhjd->bhjqm', q, k).astype(jnp.float32) * ATTN_SCALE
    p = jax.nn.softmax(s, axis=-1)
    a = (p[:, :, 0] - lam * p[:, :, 1]).astype(v.dtype)
    o = jnp.einsum('bhqm,bmhe->bqhe', a, v)
    o = _rms_norm(o, subln) * (1.0 - lam_init)
    return o.reshape(o.shape[:2] + (-1,))


def _neighbourhood_attention(q, k, v, k_ctx, v_ctx, rpb):
    b, n, h, d = q.shape
    rows = n // GRID_W
    kh = min(WIN_H, rows)
    r = jnp.arange(rows)
    cidx = jnp.arange(GRID_W)
    row_idx = jnp.clip(r - kh // 2, 0, rows - kh)[:, None] + jnp.arange(kh)[None, :]
    col_idx = jnp.clip(cidx - WIN_W // 2, 0, GRID_W - WIN_W)[:, None] + jnp.arange(WIN_W)[None, :]
    dr = (row_idx - r[:, None] + WIN_H - 1)[:, None, :, None]
    dc = (col_idx - cidx[:, None] + WIN_W - 1)[None, :, None, :]
    bias = rpb[:, dr, dc].astype(jnp.float32)
    kg = k.reshape(b, rows, GRID_W, h, d)
    vg = v.reshape(b, rows, GRID_W, h, d)
    rb = Q_BLOCK // GRID_W
    nb = rows // rb
    qg = jnp.moveaxis(q.reshape(b, nb, rb, GRID_W, h, d), 1, 0)
    ridx = row_idx.reshape(nb, rb, kh)
    bb = jnp.moveaxis(bias.reshape(h, nb, rb, GRID_W, kh, WIN_W), 1, 0)
    nwin = kh * WIN_W

    def block(args):
        qblk, ri, bi = args
        k_win = kg[:, ri][:, :, :, col_idx]
        v_win = vg[:, ri][:, :, :, col_idx]
        s_win = jnp.einsum('brchd,brkcwhd->bhrckw', qblk, k_win).astype(jnp.float32) * ATTN_SCALE + bi
        s_ctx = jnp.einsum('brchd,blhd->bhrcl', qblk, k_ctx).astype(jnp.float32) * ATTN_SCALE
        s = jnp.concatenate([s_win.reshape(b, h, rb, GRID_W, nwin), s_ctx], axis=-1)
        p = jax.nn.softmax(s, axis=-1).astype(v.dtype)
        p_win = p[..., :nwin].reshape(b, h, rb, GRID_W, kh, WIN_W)
        return (jnp.einsum('bhrckw,brkcwhd->brchd', p_win, v_win)
                + jnp.einsum('bhrcl,blhd->brchd', p[..., nwin:], v_ctx))

    out = lax.map(block, (qg, ridx, bb))
    return jnp.moveaxis(out, 0, 1).reshape(b, n, h * d)


def _fourier_mix(f):
    b, t, _ = f.shape
    fg = f.reshape(b, t, D_GROUPS, D_GROUP_DIM).astype(jnp.float32)
    y = jnp.fft.fft2(fg, axes=(1, 3), norm='ortho').real
    return y.reshape(b, t, MIX_HALF).astype(f.dtype)


def _ffn(u, w1, w2):
    hid = jax.nn.relu(u @ w1)
    return (hid * hid) @ w2


def _mixer_ab(ux, uc, w_in, w_out, q_norm, k_norm, lam_p, subln, lam_init, cos, sin, last):
    b, n, _ = ux.shape
    l = uc.shape[1]

    def split_q(hq, t):
        qa = hq[..., :QA_W].reshape(b, t, A_KV_HEADS, A_GROUP, HEAD_DIM)
        qb = hq[..., QA_W:].reshape(b, t, B_HEADS, 2, HEAD_DIM)
        return qa, qb

    def split_kv(hkv, t):
        o1 = KA_W
        o2 = o1 + VA_W
        o3 = o2 + KB_W
        ka = hkv[..., :o1].reshape(b, t, A_KV_HEADS, HEAD_DIM)
        va = hkv[..., o1:o2].reshape(b, t, A_KV_HEADS, HEAD_DIM)
        kb = hkv[..., o2:o3].reshape(b, t, B_HEADS, 2, HEAD_DIM)
        vb = hkv[..., o3:].reshape(b, t, B_HEADS, B_V_DIM)
        return ka, va, kb, vb

    hx = ux @ w_in
    qa, qb = split_q(hx[..., :AB_Q_W], n)
    ka, va, kb, vb = split_kv(hx[..., AB_Q_W:], n)
    ka_c, va_c, kb_c, vb_c = split_kv(uc @ w_in[:, AB_Q_W:], l)
    ka_c = _rms_norm(ka_c, k_norm)
    lp = lam_p.astype(jnp.float32)
    lam = jnp.exp(jnp.sum(lp[0] * lp[1])) - jnp.exp(jnp.sum(lp[2] * lp[3])) + lam_init

    qa = _apply_rope(_rms_norm(qa, q_norm), cos, sin)
    ka_all = jnp.concatenate([_apply_rope(_rms_norm(ka, k_norm), cos, sin), ka_c], axis=1)
    va_all = jnp.concatenate([va, va_c], axis=1)
    qb = _apply_rope(qb, cos, sin)
    kb_all = jnp.concatenate([_apply_rope(kb, cos, sin), kb_c], axis=1)
    vb_all = jnp.concatenate([vb, vb_c], axis=1)
    o_a = _sweep(qa, lambda qblk: _gqa_core(qblk, ka_all, va_all))
    o_b = _sweep(qb, lambda qblk: _diff_core(qblk, kb_all, vb_all, lam, lam_init, subln))
    out_x = jnp.concatenate([o_a, o_b], axis=-1) @ w_out
    if last:
        return out_x, None
    qa_c, qb_c = split_q(uc @ w_in[:, :AB_Q_W], l)
    o_a_c = _gqa_core(_rms_norm(qa_c, q_norm), ka_c, va_c)
    o_b_c = _diff_core(qb_c, kb_c, vb_c, lam, lam_init, subln)
    out_c = jnp.concatenate([o_a_c, o_b_c], axis=-1) @ w_out
    return out_x, out_c


def _mixer_cd(ux, uc, w_in, w_out, rpb, last):
    b, n, _ = ux.shape
    l = uc.shape[1]
    hx = ux @ w_in
    qc = hx[..., :C_W].reshape(b, n, C_HEADS, HEAD_DIM)
    fd = hx[..., C_W:CD_Q_W]
    kc = hx[..., CD_Q_W:CD_Q_W + C_W].reshape(b, n, C_HEADS, HEAD_DIM)
    vc = hx[..., CD_Q_W + C_W:].reshape(b, n, C_HEADS, HEAD_DIM)
    hc = uc @ w_in[:, CD_Q_W:]
    kc_c = hc[..., :C_W].reshape(b, l, C_HEADS, HEAD_DIM)
    vc_c = hc[..., C_W:].reshape(b, l, C_HEADS, HEAD_DIM)
    o_c = _neighbourhood_attention(qc, kc, vc, kc_c, vc_c, rpb)
    o_d = _fourier_mix(fd)
    out_x = jnp.concatenate([o_c, o_d], axis=-1) @ w_out
    if last:
        return out_x, None
    hq_c = uc @ w_in[:, :CD_Q_W]
    qc_c = hq_c[..., :C_W].reshape(b, l, C_HEADS, 1, HEAD_DIM)
    o_c_c = _gqa_core(qc_c, kc_c, vc_c)
    o_d_c = _fourier_mix(hq_c[..., C_W:])
    out_c = jnp.concatenate([o_c_c, o_d_c], axis=-1) @ w_out
    return out_x, out_c


def setup_inputs(seed: int = 0) -> dict:
    key = jax.random.key(seed)
    ks = jax.random.split(key, 19)

    def nrm(k, shape, s):
        return jax.random.normal(k, shape, jnp.float32) * s

    return {
        'x': nrm(ks[0], (BATCH, SEQ, D_MODEL), 1.0),
        'c': nrm(ks[1], (BATCH, D_MODEL), 1.0),
        'ctx': nrm(ks[2], (BATCH, CTX_LEN, D_MODEL), 1.0),
        'c_ctx': nrm(ks[3], (D_MODEL,), 1.0),
        'mod_w': nrm(ks[4], (DEPTH, D_MODEL, 6 * D_MODEL), 0.5 * D_MODEL ** -0.5),
        'mod_b': nrm(ks[5], (DEPTH, 6 * D_MODEL), 0.02),
        'ln_g': 1.0 + nrm(ks[6], (DEPTH, 2, D_MODEL), 0.02),
        'ln_b': nrm(ks[7], (DEPTH, 2, D_MODEL), 0.02),
        'ffn_w1': nrm(ks[8], (DEPTH, D_MODEL, FFN_DIM), D_MODEL ** -0.5),
        'ffn_w2': nrm(ks[9], (DEPTH, FFN_DIM, D_MODEL), BETA * FFN_DIM ** -0.5),
        'ab_w_in': nrm(ks[10], (N_EVEN, D_MODEL, AB_IN_W), D_MODEL ** -0.5),
        'ab_w_out': nrm(ks[11], (N_EVEN, AB_OUT_IN, D_MODEL), BETA * AB_OUT_IN ** -0.5),
        'a_q_norm': 1.0 + nrm(ks[12], (N_EVEN, HEAD_DIM), 0.02),
        'a_k_norm': 1.0 + nrm(ks[13], (N_EVEN, HEAD_DIM), 0.02),
        'b_lambda': nrm(ks[14], (N_EVEN, 4, HEAD_DIM), 0.1),
        'b_subln': 1.0 + nrm(ks[15], (N_EVEN, B_V_DIM), 0.02),
        'cd_w_in': nrm(ks[16], (N_ODD, D_MODEL, CD_IN_W), D_MODEL ** -0.5),
        'cd_w_out': nrm(ks[17], (N_ODD, CD_OUT_IN, D_MODEL), BETA * CD_OUT_IN ** -0.5),
        'c_rpb': nrm(ks[18], (N_ODD, C_HEADS, 2 * WIN_H - 1, 2 * WIN_W - 1), 0.1),
    }


def reference(x, c, ctx, c_ctx, mod_w, mod_b, ln_g, ln_b, ffn_w1, ffn_w2, ab_w_in, ab_w_out,
              a_q_norm, a_k_norm, b_lambda, b_subln, cd_w_in, cd_w_out, c_rpb):
    cos, sin = _axial_rope_tables(x.shape[1], x.dtype)
    sc = jax.nn.silu(c)
    scc = jax.nn.silu(c_ctx)
    for i in range(DEPTH):
        last = i == DEPTH - 1
        j = i // 2
        mx = (sc @ mod_w[i] + mod_b[i])[:, None, :]
        sh1, s1, g1, sh2, s2, g2 = jnp.split(mx, 6, axis=-1)
        n_ctx_mod = 2 if last else 6
        mc = scc @ mod_w[i][:, :n_ctx_mod * D_MODEL] + mod_b[i][:n_ctx_mod * D_MODEL]
        mcs = jnp.split(mc, n_ctx_mod)
        ux = x * (1 + s1) + sh1
        uc = ctx * (1 + mcs[1]) + mcs[0]
        if i % 2 == 0:
            lam_init = 0.8 - 0.6 * math.exp(-0.3 * i)
            ox, oc = _mixer_ab(ux, uc, ab_w_in[j], ab_w_out[j], a_q_norm[j], a_k_norm[j],
                               b_lambda[j], b_subln[j], lam_init, cos, sin, last)
        else:
            ox, oc = _mixer_cd(ux, uc, cd_w_in[j], cd_w_out[j], c_rpb[j], last)
        x = _layer_norm(ALPHA * x + g1 * ox, ln_g[i, 0], ln_b[i, 0])
        x = _layer_norm(ALPHA * x + g2 * _ffn(x * (1 + s2) + sh2, ffn_w1[i], ffn_w2[i]), ln_g[i, 1], ln_b[i, 1])
        if not last:
            ctx = _layer_norm(ALPHA * ctx + mcs[2] * oc, ln_g[i, 0], ln_b[i, 0])
            ctx = _layer_norm(ALPHA * ctx + mcs[5] * _ffn(ctx * (1 + mcs[4]) + mcs[3], ffn_w1[i], ffn_w2[i]),
                              ln_g[i, 1], ln_b[i, 1])
    return x
```

```cpp
#include <hip/hip_runtime.h>
#include <cstdio>
#include <cstdint>
namespace pg8 {
#define PG8_LAS __attribute__((address_space(3)))
typedef unsigned short bf16_t;
typedef short bf16x8 __attribute__((ext_vector_type(8)));
typedef float f32x4 __attribute__((ext_vector_type(4)));
typedef unsigned u32x4 __attribute__((ext_vector_type(4)));
constexpr int BM = 256, BK = 64, HALF = 128, HTB = HALF * BK * 2  , STAGE_BYTES = 8 * HTB, NXCD = 8, WGM = 8;

__host__ __device__ __forceinline__ int lds_byte(int r, int c) { const int st = (r >> 4) * 2 + (c >> 5), rr = r & 15, cc = c & 31, ob = rr * 64 + cc * 2; return st * 1024 + (ob ^ (((ob >> 9) & 1) << 5)); }
__host__ __device__ __forceinline__ void stage_rc(int b, int& R, int& C) { const int st = b / 1024, sb = b % 1024, swz = sb ^ (((sb >> 9) & 1) << 5); R = (st >> 1) * 16 + swz / 64; C = (st & 1) * 32 + (swz % 64) / 2; }
__host__ __device__ __forceinline__ int perm32(int rho) { const int n = rho >> 4, i = rho & 15; return 8 * (i >> 2) + 4 * n + (i & 3); }

struct Unit { int pm, pn; size_t aoff, boff; };
struct Gemm { const bf16_t* A; const bf16_t* Bt; int lda, ldb, K; };


template <int KIND> struct Sched {
    int nM, nN, nwg, G, c; size_t lda2, ldb2;
    __device__ __forceinline__ void init(int nM_, int nN_, int G_, int c_, int lda, int ldb) { nM = nM_; nN = nN_; nwg = nM * nN; G = G_; c = c_; lda2 = (size_t)lda * 2; ldb2 = (size_t)ldb * 2; }
    __device__ __forceinline__ bool next(int i, Unit& u) const {
        if constexpr (KIND == 3) {
            if (i > 0 || c >= 128) return false;
            const int b = c >> 4, s = c & 15; u.pm = s >> 1; u.pn = b * 2 + (s & 1);
            u.aoff = (size_t)u.pm * 256 * lda2; u.boff = (size_t)b * 4096 * 2 + (size_t)(s & 1) * 256 * ldb2; return true;
        } else {
            const long L = (long)i * G + c; if (L >= nwg) return false;
            int wgid = (int)L; { const int q = nwg / NXCD, r = nwg % NXCD, xcd = wgid % NXCD, off = wgid / NXCD; wgid = (xcd < r ? xcd * (q + 1) : r * (q + 1) + (xcd - r) * q) + off; }
            const int nig = WGM * nN, gid = wgid / nig, fm = gid * WGM, gsz = (nM - fm) < WGM ? (nM - fm) : WGM;
            const int lpm = fm + ((wgid % nig) % gsz), lpn = (wgid % nig) / gsz;
            if constexpr (KIND == 0) { u.pm = lpm; u.pn = lpn; }
            else if constexpr (KIND == 1) { u.pm = (lpm >> 3) * 9 + (lpm & 7); u.pn = lpn; }
            else { u.pm = lpm; u.pn = (lpn >> 3) * 9 + (lpn & 7); }
            u.aoff = (size_t)u.pm * 256 * lda2; u.boff = (size_t)u.pn * 256 * ldb2; return true;
        }
    }
    __device__ __forceinline__ void a_ready(const Unit&) const {}
    __device__ __forceinline__ void done(const Unit&) const {}
};

__device__ __forceinline__ unsigned cvt_pk_bf16(float lo, float hi) { unsigned r; asm volatile("v_cvt_pk_bf16_f32 %0, %1, %2" : "=v"(r) : "v"(lo), "v"(hi)); return r; }

template <int KIND> struct EpiB {
    static constexpr bool PERM = true, AFTER_DRAIN = false;
    bf16_t* O; int ldc; float scale;
    __device__ __forceinline__ void operator()(const f32x4 (&acc)[2][2][4][2], const Unit& u, int wr, int wc, int fr, int fq) const {
        const int r0 = wr * 64 + fr, c0 = wc * 32 + 8 * fq;
#pragma unroll
        for (int ai = 0; ai < 2; ++ai)
#pragma unroll
            for (int m = 0; m < 4; ++m) {
                const int r = r0 + ai * HALF + m * 16;
                bf16_t* rowp;
                if constexpr (KIND == 0 || KIND == 1 || KIND == 4) rowp = O + (size_t)(u.pm * BM + r) * ldc + u.pn * BM + c0;
                else if constexpr (KIND == 2) { const int R = u.pm * BM + r, cs = R >> 9, gk = R & 511, b = u.pn / 9, t0 = (u.pn % 9) * 256; rowp = O + ((size_t)((gk * 8 + b) * 2 + cs)) * 2048 + t0 + c0; }
                else { const int b = u.pn >> 1, half = u.pn & 1; rowp = O + (size_t)(b * 2304 + u.pm * BM + r) * ldc + 512 + half * 256 + c0; }
#pragma unroll
                for (int bj = 0; bj < 2; ++bj) { f32x4 v0 = acc[ai][bj][m][0], v1 = acc[ai][bj][m][1];
                    if constexpr (KIND == 1) {
#pragma unroll
                        for (int e = 0; e < 4; ++e) { const float a0 = fmaxf(v0[e], 0.f), a1 = fmaxf(v1[e], 0.f); v0[e] = a0 * a0; v1[e] = a1 * a1; } }
                    if constexpr (KIND == 3) { v0 = v0 * scale; v1 = v1 * scale; }
                    if constexpr (KIND == 4) { const float sc = (u.pn < 2) ? scale : 1.f; v0 = v0 * sc; v1 = v1 * sc; }
                    u32x4 w; w.x = cvt_pk_bf16(v0[0], v0[1]); w.y = cvt_pk_bf16(v0[2], v0[3]); w.z = cvt_pk_bf16(v1[0], v1[1]); w.w = cvt_pk_bf16(v1[2], v1[3]);
                    *(u32x4*)(rowp + bj * HALF) = w; } }
    }
};
struct EpiRes {
    static constexpr bool PERM = false, AFTER_DRAIN = false;
    const float* rx; int rsx; const float* rc; int rsc; float* ox; int osx; float* oc; int osc; const float* gate; float alpha;
    __device__ __forceinline__ void operator()(const f32x4 (&acc)[2][2][4][2], const Unit& u, int wr, int wc, int fr, int fq) const {
        const int b = u.pm / 9, jt = u.pm % 9;
        const float* res = (jt < 8) ? rx + ((size_t)b * rsx + jt * 256) * 1024 : rc + ((size_t)b * rsc) * 1024;
        float* out = (jt < 8) ? ox + ((size_t)b * osx + jt * 256) * 1024 : oc + ((size_t)b * osc) * 1024;
        const float* gt = gate + (size_t)((jt < 8) ? b : 8) * 6144;
        const int col0 = u.pn * BM + wc * 32 + 4 * fq;
        f32x4 gv[2][2];
#pragma unroll
        for (int bj = 0; bj < 2; ++bj)
#pragma unroll
            for (int n = 0; n < 2; ++n) gv[bj][n] = *(const f32x4*)(gt + col0 + bj * HALF + n * 16);
#pragma unroll
        for (int ai = 0; ai < 2; ++ai)
#pragma unroll
            for (int m = 0; m < 4; ++m) { const size_t off = (size_t)(ai * HALF + wr * 64 + m * 16 + fr) * 1024 + col0;
#pragma unroll
                for (int bj = 0; bj < 2; ++bj)
#pragma unroll
                    for (int n = 0; n < 2; ++n) { const f32x4 rv = *(const f32x4*)(res + off + bj * HALF + n * 16); *(f32x4*)(out + off + bj * HALF + n * 16) = rv * alpha + gv[bj][n] * acc[ai][bj][m][n]; }
                asm volatile("" ::: "memory"); }
    }
};

template <class Epi, class Sched, bool ALIGN_EPI = false, bool SP2 = false>
__device__ __forceinline__ void gemm_phase(PG8_LAS unsigned char* lds, const Gemm g, const Sched& S, const Epi& E) {
    const int tid = threadIdx.x, wid = __builtin_amdgcn_readfirstlane(tid >> 6), lane = tid & 63, wr = wid >> 2, wc = wid & 3, fr = lane & 15, fq = lane >> 4;
    const int K = g.K, nt = K / BK;
    unsigned voffA[2], voffB[2];
#pragma unroll
    for (int i = 0; i < 2; ++i) { int R, C; stage_rc(tid * 16 + i * 8192, R, C); const int Rb = Epi::PERM ? ((R & ~31) + perm32(R & 31)) : R;
        voffA[i] = (unsigned)(R * g.lda + C) * 2u; voffB[i] = (unsigned)(Rb * g.ldb + C) * 2u; }
    const size_t kstep = (size_t)(BK * 2);
    const size_t hstepA = (size_t)HALF * g.lda * 2, hstepB = (size_t)HALF * g.ldb * 2;
    const unsigned ldsw = (unsigned)wid * 1024u;
    const int aoff = lds_byte(wr * 64 + fr, fq * 8), boff = lds_byte(wc * 32 + fr, fq * 8);
#define PG8_SA(b, h) (((b) * 2 + (h)) * HTB)
#define PG8_SB(b, h) ((4 + (b) * 2 + (h)) * HTB)
#define PG8_STAGE(bufoff, gbase, voff) do { _Pragma("unroll") for (int _i = 0; _i < 2; ++_i) \
        __builtin_amdgcn_global_load_lds((const unsigned*)((const char*)(gbase) + (voff)[_i]), (PG8_LAS unsigned*)(lds + (bufoff) + ldsw + _i * 8192), 16, 0, 0); } while (0)
#define PG8_LDA(dst, b, h) do { _Pragma("unroll") for (int m = 0; m < 4; ++m) _Pragma("unroll") for (int k = 0; k < 2; ++k) dst[m][k] = *(const PG8_LAS bf16x8*)(lds + PG8_SA(b, h) + aoff + m * 2048 + k * 1024); } while (0)
#define PG8_LDB(dst, b, h) do { _Pragma("unroll") for (int n = 0; n < 2; ++n) _Pragma("unroll") for (int k = 0; k < 2; ++k) dst[n][k] = *(const PG8_LAS bf16x8*)(lds + PG8_SB(b, h) + boff + n * 2048 + k * 1024); } while (0)
#define PG8_MMA(ai, bj, At, Bt) do { __builtin_amdgcn_s_setprio(1); _Pragma("unroll") for (int m = 0; m < 4; ++m) _Pragma("unroll") for (int n = 0; n < 2; ++n) _Pragma("unroll") for (int k = 0; k < 2; ++k) \
        acc[ai][bj][m][n] = __builtin_amdgcn_mfma_f32_16x16x32_bf16(Bt[n][k], At[m][k], acc[ai][bj][m][n], 0, 0, 0); __builtin_amdgcn_s_setprio(0); } while (0)
#define PG8_WAIT_V(n) asm volatile("s_waitcnt vmcnt(" #n ")" ::: "memory")
#define PG8_WAIT_L(n) asm volatile("s_waitcnt lgkmcnt(" #n ")" ::: "memory")
#define PG8_BAR __builtin_amdgcn_s_barrier()
#define PG8_SCHED __builtin_amdgcn_sched_barrier(0)
    Unit cur, nxt; int ui = 0;
    if (!S.next(0, cur)) return;
    f32x4 acc[2][2][4][2];
#pragma unroll
    for (int a = 0; a < 2; ++a)
#pragma unroll
        for (int b = 0; b < 2; ++b)
#pragma unroll
            for (int m = 0; m < 4; ++m)
#pragma unroll
                for (int n = 0; n < 2; ++n) acc[a][b][m][n] = (f32x4){0.f, 0.f, 0.f, 0.f};
    bf16x8 At[4][2], B0[2][2], B1[2][2];
    const char* cA = (const char*)g.A + cur.aoff; const char* cB = (const char*)g.Bt + cur.boff;
    S.a_ready(cur);
    if constexpr (SP2) {
        PG8_STAGE(PG8_SB(0, 0), cB, voffB); PG8_STAGE(PG8_SB(0, 1), cB + hstepB, voffB); PG8_STAGE(PG8_SA(0, 0), cA, voffA); PG8_STAGE(PG8_SA(0, 1), cA + hstepA, voffA);
        if (wr == 1) PG8_BAR;
        PG8_WAIT_V(2); PG8_BAR;
        PG8_STAGE(PG8_SB(1, 0), cB + kstep, voffB); PG8_STAGE(PG8_SA(1, 0), cA + kstep, voffA); PG8_STAGE(PG8_SB(1, 1), cB + hstepB + kstep, voffB);
        PG8_WAIT_V(6); PG8_BAR;
    } else {
        PG8_STAGE(PG8_SB(0, 0), cB, voffB); PG8_STAGE(PG8_SA(0, 0), cA, voffA); PG8_STAGE(PG8_SB(0, 1), cB + hstepB, voffB); PG8_STAGE(PG8_SA(0, 1), cA + hstepA, voffA);
        if (wr == 1) PG8_BAR;
        PG8_WAIT_V(4); PG8_BAR;
        PG8_STAGE(PG8_SB(1, 0), cB + kstep, voffB); PG8_STAGE(PG8_SA(1, 0), cA + kstep, voffA); PG8_STAGE(PG8_SB(1, 1), cB + hstepB + kstep, voffB);
        PG8_WAIT_V(6); PG8_BAR;
    }
    for (;;) {
        const bool has_next = S.next(ui + 1, nxt);
        const char* nA = has_next ? (const char*)g.A + nxt.aoff : cA; const char* nB = has_next ? (const char*)g.Bt + nxt.boff : cB;
        for (int t = 0; t < nt; t += 2) {
            const bool last = (t == nt - 2);
            const char* a1 = cA + (size_t)(t + 1) * kstep;
            const char* a2 = last ? nA : cA + (size_t)(t + 2) * kstep; const char* b2 = last ? nB : cB + (size_t)(t + 2) * kstep;
            const char* a3 = a2 + kstep; const char* b3 = b2 + kstep;
            if (last && has_next) S.a_ready(nxt);
            if constexpr (SP2) {
            PG8_LDB(B0, 0, 0); PG8_LDB(B1, 0, 1); PG8_SCHED; PG8_LDA(At, 0, 0); PG8_STAGE(PG8_SA(1, 1), a1 + hstepA, voffA);
            PG8_WAIT_V(8); PG8_WAIT_L(0); PG8_BAR; PG8_MMA(0, 0, At, B0); PG8_MMA(0, 1, At, B1); PG8_BAR; PG8_SCHED;
            PG8_LDA(At, 0, 1); PG8_STAGE(PG8_SB(0, 0), b2, voffB); PG8_STAGE(PG8_SB(0, 1), b2 + hstepB, voffB); PG8_STAGE(PG8_SA(0, 0), a2, voffA);
            PG8_WAIT_V(8); PG8_WAIT_L(0); PG8_BAR; PG8_MMA(1, 0, At, B0); PG8_MMA(1, 1, At, B1); PG8_BAR; PG8_SCHED;
            PG8_LDB(B0, 1, 0); PG8_LDB(B1, 1, 1); PG8_SCHED; PG8_LDA(At, 1, 0); PG8_STAGE(PG8_SA(0, 1), a2 + hstepA, voffA);
            PG8_WAIT_V(8); PG8_WAIT_L(0); PG8_BAR; PG8_MMA(0, 0, At, B0); PG8_MMA(0, 1, At, B1); PG8_BAR; PG8_SCHED;
            PG8_LDA(At, 1, 1); PG8_STAGE(PG8_SB(1, 0), b3, voffB); PG8_STAGE(PG8_SB(1, 1), b3 + hstepB, voffB); PG8_STAGE(PG8_SA(1, 0), a3, voffA);
            PG8_WAIT_V(8); PG8_WAIT_L(0); PG8_BAR; PG8_MMA(1, 0, At, B0); PG8_MMA(1, 1, At, B1); PG8_BAR; PG8_SCHED;
            } else {
            PG8_LDB(B0, 0, 0); PG8_SCHED; PG8_LDA(At, 0, 0); PG8_STAGE(PG8_SA(1, 1), a1 + hstepA, voffA);
            PG8_WAIT_L(8); PG8_BAR; PG8_WAIT_L(0); PG8_MMA(0, 0, At, B0); PG8_BAR; PG8_SCHED;
            PG8_LDB(B1, 0, 1); PG8_STAGE(PG8_SB(0, 0), b2, voffB);
            PG8_BAR; PG8_WAIT_L(0); PG8_MMA(0, 1, At, B1); PG8_BAR;
            PG8_LDA(At, 0, 1); PG8_STAGE(PG8_SA(0, 0), a2, voffA);
            PG8_BAR; PG8_WAIT_L(0); PG8_MMA(1, 0, At, B0); PG8_BAR; PG8_SCHED;
            PG8_STAGE(PG8_SB(0, 1), b2 + hstepB, voffB);
            PG8_WAIT_V(6); PG8_BAR; PG8_MMA(1, 1, At, B1); PG8_BAR;
            PG8_LDB(B0, 1, 0); PG8_SCHED; PG8_LDA(At, 1, 0); PG8_STAGE(PG8_SA(0, 1), a2 + hstepA, voffA);
            PG8_WAIT_L(8); PG8_BAR; PG8_WAIT_L(0); PG8_MMA(0, 0, At, B0); PG8_BAR; PG8_SCHED;
            PG8_LDB(B1, 1, 1); PG8_STAGE(PG8_SB(1, 0), b3, voffB);
            PG8_BAR; PG8_WAIT_L(0); PG8_MMA(0, 1, At, B1); PG8_BAR;
            PG8_LDA(At, 1, 1); PG8_STAGE(PG8_SA(1, 0), a3, voffA);
            PG8_BAR; PG8_WAIT_L(0); PG8_MMA(1, 0, At, B0); PG8_BAR; PG8_SCHED;
            PG8_STAGE(PG8_SB(1, 1), b3 + hstepB, voffB);
            PG8_WAIT_V(6); PG8_BAR; PG8_MMA(1, 1, At, B1); PG8_BAR;
            }
        }
        if constexpr (ALIGN_EPI) { if (wr == 0) PG8_BAR; }
        if constexpr (!Epi::AFTER_DRAIN) { E(acc, cur, wr, wc, fr, fq); S.done(cur); }
        if (!has_next) break;
#pragma unroll
        for (int a = 0; a < 2; ++a)
#pragma unroll
            for (int b = 0; b < 2; ++b)
#pragma unroll
                for (int m = 0; m < 4; ++m)
#pragma unroll
                    for (int n = 0; n < 2; ++n) acc[a][b][m][n] = (f32x4){0.f, 0.f, 0.f, 0.f};
        cur = nxt; cA = nA; cB = nB; ++ui;
        if constexpr (ALIGN_EPI) { if (wr == 1) PG8_BAR; }
    }
    PG8_WAIT_V(0);
    if constexpr (!ALIGN_EPI) { if (wr == 0) PG8_BAR; }
    PG8_BAR;
    if constexpr (Epi::AFTER_DRAIN) { E.fused(acc, cur, wr, wc, fr, fq, lds, wid, lane); S.done(cur); }
#undef PG8_SA
#undef PG8_SB
#undef PG8_STAGE
#undef PG8_LDA
#undef PG8_LDB
#undef PG8_MMA
#undef PG8_WAIT_V
#undef PG8_WAIT_L
#undef PG8_BAR
#undef PG8_SCHED
}
}

#ifndef PG8_SP2
#define PG8_SP2 true
#endif
#ifndef PG8_ALIGN
#define PG8_ALIGN true
#endif
#include <hip/hip_bf16.h>
#include <cmath>
namespace attn_body {
using bf16=__hip_bfloat16;
using bf16x8=__attribute__((ext_vector_type(8)))short;
using s16x4=__attribute__((ext_vector_type(4)))short;
using f32x16=__attribute__((ext_vector_type(16)))float;
using u32x4=__attribute__((ext_vector_type(4)))unsigned;
constexpr int D=64;
constexpr int NW=8,QBLK=32,QB=QBLK*NW,KVBLK=64;
constexpr int ATTN_UNIT_ROWS=QB;
__device__ __forceinline__ int crow(int r,int hi){return (r&3)+8*(r>>2)+4*hi;}
#define SBAR() __builtin_amdgcn_sched_barrier(0)
typedef __attribute__((address_space(3))) const float* lds_cfptr;
__device__ __forceinline__ void namask(f32x16&p0,f32x16&p1,int t,int frow,int qrow,int lo,lds_cfptr tb,float mh){
  if(t<4){
    #pragma unroll
    for(int r=0;r<16;++r){p0[r]-=mh;p1[r]-=mh;}
    return; }
  const float NEG=-INFINITY; const int kr=frow+t-4; int rs=qrow-4; rs=rs<0?0:(rs>24?24:rs);
  if(kr<rs||kr>=rs+8){
    #pragma unroll
    for(int r=0;r<16;++r){p0[r]=NEG;p1[r]=NEG;}
    return; }
  const lds_cfptr trow=tb+(kr-qrow+7)*31;
  #pragma unroll
  for(int r=0;r<16;++r){ const int cr=(r&3)+8*(r>>2);
    const float b1=trow[cr]-mh, b2=trow[cr+32]-mh;
    p0[r]=((unsigned)(cr-lo)<16u)?p0[r]+b1:NEG; p1[r]=((unsigned)(cr+32-lo)<16u)?p1[r]+b2:NEG; }
}
template<int MODE> __device__ __forceinline__ f32x16 cinit(const f32x16&negm){ if constexpr(MODE==1){ return f32x16{}; } else { return negm; } }

constexpr int NSLOT=3, SLOTB=8192;
constexpr int LDS_K=0, LDS_V=NSLOT*SLOTB, LDS_WS=2*NSLOT*SLOTB, LDS_OST=LDS_WS+NW*64*4, LDS_BYTES=LDS_OST+NW*4096;
constexpr float C2=0.125f*1.4426950408889634f;
__device__ __forceinline__ void glds16(const void*gsrc,unsigned lds_dst){unsigned keep;
  asm volatile("s_mov_b32 %0, m0\n\ts_mov_b32 m0, %2\n\ts_nop 0\n\tglobal_load_lds_dwordx4 %1, off\n\ts_mov_b32 m0, %0":"=&s"(keep):"v"(gsrc),"s"(lds_dst):"memory");}
__device__ __forceinline__ float max3f(float a,float b,float c){float r;asm("v_max3_f32 %0, %1, %2, %3":"=v"(r):"v"(a),"v"(b),"v"(c));return r;}
__device__ __forceinline__ float max2f(float a,float b){float r;asm("v_max_f32_e32 %0, %1, %2":"=v"(r):"v"(a),"v"(b));return r;}
__device__ __forceinline__ float fadd_s(float a,float b){float r;asm("v_add_f32_e32 %0, %1, %2":"=v"(r):"v"(a),"v"(b));return r;}
__device__ __forceinline__ float fsub_s(float a,float b){float r;asm("v_sub_f32_e32 %0, %1, %2":"=v"(r):"v"(a),"v"(b));return r;}
typedef float f32x2_t __attribute__((ext_vector_type(2))); typedef __bf16 bf16x2_t __attribute__((ext_vector_type(2)));
__device__ __forceinline__ unsigned cvtpk_s(float lo,float hi){f32x2_t v={lo,hi};bf16x2_t b=__builtin_convertvector(v,bf16x2_t);return __builtin_bit_cast(unsigned,b);}
#define WAIT_BAR(N) asm volatile("s_waitcnt vmcnt(" #N ") lgkmcnt(0)\n\ts_barrier":::"memory")

__device__ __forceinline__ void qkt(f32x16&p0,f32x16&p1,const char*Kslot,const bf16x8*qr,const f32x16&negm,int r32,int hi){
  const char*kb=Kslot+hi*1024+r32*16;
  #pragma unroll
  for(int d0=0;d0<4;++d0){
    const bf16x8 b0=*reinterpret_cast<const bf16x8*>(kb+d0*2048);
    const bf16x8 b1=*reinterpret_cast<const bf16x8*>(kb+d0*2048+512);
    if(d0==0){p0=__builtin_amdgcn_mfma_f32_32x32x16_bf16(b0,qr[0],negm,0,0,0);p1=__builtin_amdgcn_mfma_f32_32x32x16_bf16(b1,qr[0],negm,0,0,0);}
    else{p0=__builtin_amdgcn_mfma_f32_32x32x16_bf16(b0,qr[d0],p0,0,0,0);p1=__builtin_amdgcn_mfma_f32_32x32x16_bf16(b1,qr[d0],p1,0,0,0);}}
}
typedef __attribute__((address_space(3))) const char* lds_cptr;
typedef short v4i16_t __attribute__((ext_vector_type(4)));
__device__ __forceinline__ void kload8(bf16x8*kf,lds_cptr kp){
  kf[0]=*(const __attribute__((address_space(3))) bf16x8*)(kp);      kf[1]=*(const __attribute__((address_space(3))) bf16x8*)(kp+512);
  kf[2]=*(const __attribute__((address_space(3))) bf16x8*)(kp+2048); kf[3]=*(const __attribute__((address_space(3))) bf16x8*)(kp+2560);
  kf[4]=*(const __attribute__((address_space(3))) bf16x8*)(kp+4096); kf[5]=*(const __attribute__((address_space(3))) bf16x8*)(kp+4608);
  kf[6]=*(const __attribute__((address_space(3))) bf16x8*)(kp+6144); kf[7]=*(const __attribute__((address_space(3))) bf16x8*)(kp+6656);
}
__device__ __forceinline__ void kload2(bf16x8*kf,lds_cptr kp,int j){ kf[2*j]=*(const __attribute__((address_space(3))) bf16x8*)(kp+j*2048); kf[2*j+1]=*(const __attribute__((address_space(3))) bf16x8*)(kp+j*2048+512); }
__device__ __forceinline__ s16x4 vtr(lds_cptr p){ return __builtin_bit_cast(s16x4,__builtin_amdgcn_ds_read_tr16_b64_v4i16((__attribute__((address_space(3))) v4i16_t*)p)); }
__device__ __forceinline__ float rowmax(const f32x16&p0,const f32x16&p1){
  float a=max3f(p0[0],p0[1],p1[0]),b=max3f(p0[2],p0[3],p1[1]);a=max3f(a,p1[2],p1[3]);
  #pragma unroll
  for(int r=4;r<16;r+=4){a=max3f(a,p0[r],p0[r+1]);b=max3f(b,p0[r+2],p0[r+3]);a=max3f(a,p1[r],p1[r+1]);b=max3f(b,p1[r+2],p1[r+3]);}
  const float m=max2f(a,b);
  auto rr=__builtin_amdgcn_permlane32_swap(__float_as_uint(m),__float_as_uint(m),false,false);
  return max2f(__uint_as_float(rr[0]),__uint_as_float(rr[1]));
}
__device__ __forceinline__ void pv(f32x16*o,int vb,bf16x8 pa0,bf16x8 pa1,bf16x8 pa2,bf16x8 pa3){
  #pragma unroll
  for(int d0=0;d0<2;++d0){s16x4 lo[4],hi[4];
    #pragma unroll
    for(int ks=0;ks<4;++ks){
      asm volatile("ds_read_b64_tr_b16 %0,%1 offset:%c2":"=&v"(lo[ks]):"v"(vb),"i"(d0*4096+ks*1024):"memory");
      asm volatile("ds_read_b64_tr_b16 %0,%1 offset:%c2":"=&v"(hi[ks]):"v"(vb),"i"(d0*4096+ks*1024+512):"memory");}
    asm volatile("s_waitcnt lgkmcnt(0)":::"memory");SBAR();
    #define PK(k) (bf16x8){lo[k][0],lo[k][1],lo[k][2],lo[k][3],hi[k][0],hi[k][1],hi[k][2],hi[k][3]}
    o[d0]=__builtin_amdgcn_mfma_f32_32x32x16_bf16(pa0,PK(0),o[d0],0,0,0);
    o[d0]=__builtin_amdgcn_mfma_f32_32x32x16_bf16(pa1,PK(1),o[d0],0,0,0);
    o[d0]=__builtin_amdgcn_mfma_f32_32x32x16_bf16(pa2,PK(2),o[d0],0,0,0);
    o[d0]=__builtin_amdgcn_mfma_f32_32x32x16_bf16(pa3,PK(3),o[d0],0,0,0);
    #undef PK
  }
}

#ifndef ATTN_STORE16
#define ATTN_STORE16(p,v) (*(u32x4*)(p)=(v))
#endif
template<int THRL,int PQ,int PO,int MODE> __device__ __forceinline__ void attn_unit(const bf16*Qu,const bf16*__restrict__ Kh,const bf16*__restrict__ Vh,bf16*Ou,int NT,int krow0,int frow,int qrow0,lds_cfptr btab,char*shm){
  const int tid=threadIdx.x,lane=tid&63,r32=lane&31,hi=lane>>5; const int wid=__builtin_amdgcn_readfirstlane(tid>>6);
  const bf16*Qw=Qu+(long)(wid*QBLK)*PQ;
  const unsigned lds0=(unsigned)(uintptr_t)shm;
  float*wsf=(float*)(shm+LDS_WS)+wid*64;
  const bf16*ksrc=Kh+(long)lane*PQ+wid*8;
  const bf16*vsrc=Vh+(long)(16*(wid&3)+(lane>>2))*PQ+(wid>>2)*32+(lane&3)*8;
  const unsigned kdst=lds0+LDS_K+wid*1024, vdst=lds0+LDS_V+wid*1024;
  #define KROW(t) ((MODE==0)?(krow0+64*(t)):(((t)<4)?(2048+64*(t)):(64*(frow+(t)-4))))
  #define DMA_K(t,slot) glds16(ksrc+(long)KROW(t)*PQ,(unsigned)__builtin_amdgcn_readfirstlane(kdst+(slot)))
  #define DMA_V(t,slot) glds16(vsrc+(long)KROW(t)*PQ,(unsigned)__builtin_amdgcn_readfirstlane(vdst+(slot)))
  const int vb0=(int)(lds0+LDS_V)+((lane>>4)&1)*32+(lane&3)*8+(4*hi+((lane&15)>>2))*64;
  const char*Kbase=shm+LDS_K; bf16x8 kf[8];
  const lds_cptr shm3=(lds_cptr)shm; const lds_cptr kp0=shm3+LDS_K+hi*1024+r32*16; const lds_cptr vp0=shm3+LDS_V+((lane>>4)&1)*32+(lane&3)*8+(4*hi+((lane&15)>>2))*64;
  DMA_K(0,0);DMA_V(0,0);DMA_K(1,SLOTB);
  bf16x8 qr[4];
  #pragma unroll
  for(int d0=0;d0<4;++d0)qr[d0]=*reinterpret_cast<const bf16x8*>(&Qw[(long)r32*PQ+d0*16+hi*8]);
  float mhat=0.f,l_reg=0.f;f32x16 o[2];o[0]=f32x16{};o[1]=f32x16{};f32x16 negm=f32x16{}; if(MODE==0){asm volatile("":"+v"(negm));}
  const int qrow=qrow0+(wid>>1), qcol=(wid&1)*32+r32;
  const int na_cs=(qcol-8)<0?0:((qcol-8)>48?48:(qcol-8)), na_lo=na_cs-4*hi; const lds_cfptr na_tb=btab+(15-qcol+4*hi);
  #define CMASK(P0,P1,t) do{ if(MODE==1) namask(P0,P1,(t),frow,qrow,na_lo,na_tb,mhat); }while(0)
  bool resc=false;
  #define START(P0,P1) do{ const float rm=rowmax(P0,P1); resc=false; \
    { const float dl=rm; mhat=fadd_s(mhat,dl); \
      _Pragma("unroll") for(int r=0;r<16;++r){P0[r]=fsub_s(P0[r],dl);P1[r]=fsub_s(P1[r],dl);} \
      if(MODE==0){ _Pragma("unroll") for(int r=0;r<16;++r)negm[r]=-mhat; asm volatile("":"+v"(negm)); } } \
    _Pragma("unroll") for(int r=0;r<16;++r)P0[r]=__builtin_amdgcn_exp2f(P0[r]); }while(0)
  #define RESC() do{ if(resc){ asm volatile("s_waitcnt lgkmcnt(0)":::"memory"); \
      _Pragma("unroll") for(int d_=0;d_<2;++d_) _Pragma("unroll") for(int r=0;r<16;++r)o[d_][r]*=wsf[crow(r,hi)]; } }while(0)
  f32x16 pA0,pA1,pB0,pB1;
  int sl_prev=0,sl_cur=0,sl_next=SLOTB;
  #define ROT() do{sl_prev=sl_cur;sl_cur=sl_next;sl_next=(sl_next==(NSLOT-1)*SLOTB)?0:sl_next+SLOTB;}while(0)
  DMA_K(2,2*SLOTB);
  WAIT_BAR(3);
  qkt(pA0,pA1,Kbase,qr,negm,r32,hi);asm volatile("s_nop 15\n\ts_nop 7":"+v"(pA0),"+v"(pA1));CMASK(pA0,pA1,0);
  START(pA0,pA1);
  _Pragma("unroll") for(int r=0;r<16;++r)pA1[r]=__builtin_amdgcn_exp2f(pA1[r]);
  WAIT_BAR(0);
  DMA_K(3,0);DMA_V(1,SLOTB);
  ROT();
  kload8(kf,kp0+sl_cur);
  WAIT_BAR(2);
  s16x4 vlo[8],vhi[8]; u32x4 pw0,pw1,pw2,pw3;
  #define PKW(P,B) cvtpk_s(P[B],P[B+1])
  #define PAF(k) __builtin_bit_cast(bf16x8,pw##k)
  #define VFR(i) (bf16x8){vlo[i][0],vlo[i][1],vlo[i][2],vlo[i][3],vhi[i][0],vhi[i][1],vhi[i][2],vhi[i][3]}
  #define PIN(x) asm volatile("":"+v"(x))
  #define MX3(a,b,c) __builtin_fmaxf(__builtin_fmaxf((a),(b)),(c))
  #define GAPA(MF,A0,A1,A2,A3,W0,W1,PW) do{ MF; sacc+=A0; sacc+=A1; sacc+=A2; sacc+=A3; PIN(sacc); W0; W1; PIN(PW); SBAR(); }while(0)
  #define EX(v) __builtin_amdgcn_exp2f(v)
  #define GAPB(MF,X,B) do{ MF; X[B]=EX(X[B]); X[B+1]=EX(X[B+1]); X[B+2]=EX(X[B+2]); X[B+3]=EX(X[B+3]); PIN(X); SBAR(); }while(0)
  #define VRD(i) do{ vlo[i]=vtr(vp_+(((i)>>2)*4096+((i)&3)*1024)); vhi[i]=vtr(vp_+(((i)>>2)*4096+((i)&3)*1024+512)); }while(0)
  #define KRD(G,j) do{ if(G){ kload2(kf,kp0+sl_next,j); SBAR(); } }while(0)
  #define STEP(C0,C1,P0,P1,t,GK,GV,GL) do{ SBAR(); \
    const lds_cptr vp_=vp0+sl_prev; \
    VRD(0); SBAR(); float sacc=(P0[0]+P0[1]); \
    GAPA(C0=__builtin_amdgcn_mfma_f32_32x32x16_bf16(kf[0],qr[0],cinit<MODE>(negm),0,0,0), P0[2],P0[3],P0[4],P0[5],     pw0[0]=PKW(P0,0), pw0[1]=PKW(P0,2), pw0); \
    VRD(4); SBAR(); GAPA(C1=__builtin_amdgcn_mfma_f32_32x32x16_bf16(kf[1],qr[0],cinit<MODE>(negm),0,0,0), P0[6],P0[7],P0[8],P0[9],     pw0[2]=PKW(P0,4), pw0[3]=PKW(P0,6), pw0); \
    VRD(1); SBAR(); GAPA(C0=__builtin_amdgcn_mfma_f32_32x32x16_bf16(kf[2],qr[1],C0,0,0,0),   P0[10],P0[11],P0[12],P0[13], pw1[0]=PKW(P0,8), pw1[1]=PKW(P0,10), pw1); \
    VRD(5); SBAR(); GAPA(C1=__builtin_amdgcn_mfma_f32_32x32x16_bf16(kf[3],qr[1],C1,0,0,0),   P0[14],P0[15],P1[0],P1[1],   pw1[2]=PKW(P0,12),pw1[3]=PKW(P0,14), pw1); \
    VRD(2); SBAR(); GAPA(C0=__builtin_amdgcn_mfma_f32_32x32x16_bf16(kf[4],qr[2],C0,0,0,0),   P1[2],P1[3],P1[4],P1[5],     pw2[0]=PKW(P1,0), pw2[1]=PKW(P1,2), pw2); \
    VRD(6); SBAR(); GAPA(C1=__builtin_amdgcn_mfma_f32_32x32x16_bf16(kf[5],qr[2],C1,0,0,0),   P1[6],P1[7],P1[8],P1[9],     pw2[2]=PKW(P1,4), pw2[3]=PKW(P1,6), pw2); \
    VRD(3); SBAR(); GAPA(C0=__builtin_amdgcn_mfma_f32_32x32x16_bf16(kf[6],qr[3],C0,0,0,0),   P1[10],P1[11],P1[12],P1[13], pw3[0]=PKW(P1,8), pw3[1]=PKW(P1,10), pw3); \
    VRD(7); SBAR(); GAPA(C1=__builtin_amdgcn_mfma_f32_32x32x16_bf16(kf[7],qr[3],C1,0,0,0),   P1[14],P1[15],0.f,0.f,       pw3[2]=PKW(P1,12),pw3[3]=PKW(P1,14), pw3); \
    l_reg+=sacc; \
    if(GK){DMA_K((t)+3,sl_cur);} if(GV){DMA_V((t)+1,sl_next);} \
    CMASK(C0,C1,t); \
    { float a=MX3(C0[0],C0[1],C1[0]),b=MX3(C0[2],C0[3],C1[1]); a=MX3(a,C1[2],C1[3]); \
      _Pragma("unroll") for(int r=4;r<16;r+=4){a=MX3(a,C0[r],C0[r+1]);b=MX3(b,C0[r+2],C0[r+3]);a=MX3(a,C1[r],C1[r+1]);b=MX3(b,C1[r+2],C1[r+3]);} \
      float rm=__builtin_fmaxf(a,b); { auto rr=__builtin_amdgcn_permlane32_swap(__float_as_uint(rm),__float_as_uint(rm),false,false); rm=__builtin_fmaxf(__uint_as_float(rr[0]),__uint_as_float(rr[1])); } \
      resc=false; \
      if(__builtin_expect(__any(rm>(float)THRL),0)){ const float dl=__builtin_fmaxf(rm,0.f); mhat+=dl; \
        _Pragma("unroll") for(int r=0;r<16;++r){C0[r]-=dl;C1[r]-=dl;} \
        if(MODE==0){ _Pragma("unroll") for(int r=0;r<16;++r)negm[r]=-mhat; asm volatile("":"+v"(negm)); } \
        const float f=__builtin_amdgcn_exp2f(-dl); l_reg*=f; if(hi==0)wsf[r32]=f; resc=true; } } \
    SBAR(); \
    GAPB(o[0]=__builtin_amdgcn_mfma_f32_32x32x16_bf16(PAF(0),VFR(0),o[0],0,0,0), C0,0); \
    GAPB(o[1]=__builtin_amdgcn_mfma_f32_32x32x16_bf16(PAF(0),VFR(4),o[1],0,0,0), C0,4); \
    KRD(GL,0); GAPB(o[0]=__builtin_amdgcn_mfma_f32_32x32x16_bf16(PAF(1),VFR(1),o[0],0,0,0), C0,8); \
    KRD(GL,1); GAPB(o[1]=__builtin_amdgcn_mfma_f32_32x32x16_bf16(PAF(1),VFR(5),o[1],0,0,0), C0,12); \
    KRD(GL,2); GAPB(o[0]=__builtin_amdgcn_mfma_f32_32x32x16_bf16(PAF(2),VFR(2),o[0],0,0,0), C1,0); \
    KRD(GL,3); GAPB(o[1]=__builtin_amdgcn_mfma_f32_32x32x16_bf16(PAF(2),VFR(6),o[1],0,0,0), C1,4); \
    GAPB(o[0]=__builtin_amdgcn_mfma_f32_32x32x16_bf16(PAF(3),VFR(3),o[0],0,0,0), C1,8); \
    GAPB(o[1]=__builtin_amdgcn_mfma_f32_32x32x16_bf16(PAF(3),VFR(7),o[1],0,0,0), C1,12); \
    }while(0)
  int t=1;
  for(;t+5<NT;t+=2){
    STEP(pB0,pB1,pA0,pA1,t,true,true,true);     WAIT_BAR(2); RESC(); ROT();
    STEP(pA0,pA1,pB0,pB1,t+1,true,true,true);   WAIT_BAR(2); RESC(); ROT();
  }
  #define ENDW(tt) do{ if((tt)+3<NT){WAIT_BAR(2);} else if((tt)+2<NT){WAIT_BAR(1);} else {WAIT_BAR(0);} }while(0)
  for(;t+1<NT;t+=2){
    STEP(pB0,pB1,pA0,pA1,t,(t+3<NT),(t+1<NT),(t+1<NT));       ENDW(t);   RESC(); ROT();
    STEP(pA0,pA1,pB0,pB1,t+1,(t+4<NT),(t+2<NT),(t+2<NT));     ENDW(t+1); RESC(); ROT();
  }
  STEP(pB0,pB1,pA0,pA1,NT-1,false,false,false); RESC();
  { float sacc=pB0[0]+pB0[1]; _Pragma("unroll") for(int r=2;r<16;++r)sacc+=pB0[r]; _Pragma("unroll") for(int r=0;r<16;++r)sacc+=pB1[r]; l_reg+=sacc;
    pw0=(u32x4){PKW(pB0,0),PKW(pB0,2),PKW(pB0,4),PKW(pB0,6)};pw1=(u32x4){PKW(pB0,8),PKW(pB0,10),PKW(pB0,12),PKW(pB0,14)};pw2=(u32x4){PKW(pB1,0),PKW(pB1,2),PKW(pB1,4),PKW(pB1,6)};pw3=(u32x4){PKW(pB1,8),PKW(pB1,10),PKW(pB1,12),PKW(pB1,14)};
    SBAR(); pv(o,vb0+sl_cur,PAF(0),PAF(1),PAF(2),PAF(3)); }
  #undef PKW
  #undef PAF
  #undef VFR
  #undef PIN
  #undef MX3
  #undef GAPA
  #undef GAPB
  #undef EX
  #undef VRD
  #undef KRD
  #undef STEP
  #undef ENDW
  {auto rr=__builtin_amdgcn_permlane32_swap(__float_as_uint(l_reg),__float_as_uint(l_reg),false,false);l_reg=__uint_as_float(rr[0])+__uint_as_float(rr[1]);}
  if(hi==0)wsf[32+r32]=l_reg;asm volatile("s_waitcnt lgkmcnt(0)":::"memory");
  float rli[16];
  #pragma unroll
  for(int r=0;r<16;++r)rli[r]=__builtin_amdgcn_rcpf(wsf[32+crow(r,hi)]);
  bf16*Ow=Ou+(long)(wid*QBLK)*PO;
  { bf16*stg=(bf16*)(shm+LDS_OST)+wid*2048;
    #pragma unroll
    for(int r=0;r<16;++r){const int orow=crow(r,hi);
      #pragma unroll
      for(int d0=0;d0<2;++d0)stg[orow*64+d0*32+r32]=__float2bfloat16(o[d0][r]*rli[r]);}
    asm volatile("s_waitcnt lgkmcnt(0)":::"memory");
    #pragma unroll
    for(int i=0;i<4;++i){const int row=i*8+(lane>>3),ch=lane&7; const u32x4 v=*(const u32x4*)(stg+row*64+ch*8); ATTN_STORE16(Ow+(long)row*PO+ch*8,v);} }
  asm volatile("s_waitcnt lgkmcnt(0)\n\ts_barrier":::"memory");
  #undef DMA_K
  #undef KROW
  #undef DMA_V
  #undef CMASK
  #undef START
  #undef RESC
  #undef ROT
}
constexpr int ATTN_LDS_BYTES=LDS_BYTES;
#undef SBAR
#undef WAIT_BAR
}
#define GAS __attribute__((address_space(1)))
#define LAS __attribute__((address_space(3)))
typedef unsigned short bf16;
typedef unsigned v4u __attribute__((ext_vector_type(4)));
typedef float f32x4 __attribute__((ext_vector_type(4)));
typedef short bf16x8 __attribute__((ext_vector_type(8)));
typedef GAS unsigned gu32;
typedef GAS unsigned long long gu64;
#define RLX_AGENT __ATOMIC_RELAXED, __HIP_MEMORY_SCOPE_AGENT
#define LDS_WAIT() asm volatile("s_waitcnt lgkmcnt(0)" ::: "memory")
#define VM_WAIT() asm volatile("s_waitcnt vmcnt(0)" ::: "memory")
__device__ __forceinline__ unsigned long long rt() { return __builtin_amdgcn_s_memrealtime(); }
__device__ __forceinline__ unsigned f2bf(float f) { unsigned u = __builtin_bit_cast(unsigned, f); return (u + 0x7fffu + ((u >> 16) & 1u)) >> 16; }
__device__ __forceinline__ unsigned pk2(float lo, float hi) { return f2bf(lo) | (f2bf(hi) << 16); }

#define XB_TMO      128
#define XB_XCNT(j)  (256  + 64 * (j))
#define XB_XSUB(j)  (1280 + 64 * (j))
#define XB_XGEN(j)  (2304 + 64 * (j))
#define XB_TOP      3328
#define XB_TOPGEN   3392
#define XCD_BAR_WORDS 3456
#define XB_SPIN_CAP (1u << 18)

__device__ __forceinline__ unsigned xb_ld(unsigned* p)              { return __hip_atomic_load(p, __ATOMIC_RELAXED, __HIP_MEMORY_SCOPE_AGENT); }
__device__ __forceinline__ unsigned xb_add(unsigned* p, unsigned v) { return __hip_atomic_fetch_add(p, v, __ATOMIC_RELAXED, __HIP_MEMORY_SCOPE_AGENT); }
__device__ __forceinline__ unsigned xb_xcc_id() { return (unsigned)__builtin_amdgcn_s_getreg((3 << 11) | 20) & 0xFu; }
#define XB_SPIN(cond, bar) do { unsigned _sp = 0; while (cond) { __builtin_amdgcn_s_sleep(1); \
    if ((++_sp & 255u) == 0u) { if (xb_ld(&(bar)[XB_TMO])) break; if (_sp > XB_SPIN_CAP) { atomicAdd(&(bar)[XB_TMO], 1u); break; } } } } while (0)

struct XcdBarrier {
    unsigned* bar; unsigned x;
    volatile LAS unsigned* st;
};

__device__ __forceinline__ XcdBarrier xcd_barrier_post(unsigned* bar, volatile LAS unsigned* st) {
    XcdBarrier b; b.bar = bar; b.x = xb_xcc_id(); b.st = st;
    if (threadIdx.x == 0) (void)xb_add(&bar[XB_XCNT(b.x)], 1u);
    return b;
}
__device__ __forceinline__ void xcd_barrier_complete(unsigned* bar, unsigned x, unsigned& nloc, unsigned& nx) {
    const unsigned G = gridDim.x * gridDim.y * gridDim.z;
    unsigned sum, cnt, mine, sp = 0u;
    for (;;) {
        sum = 0u; cnt = 0u; mine = 0u;
#pragma unroll
        for (unsigned j = 0; j < 16; ++j) { const unsigned c = xb_ld(&bar[XB_XCNT(j)]); sum += c; cnt += (c > 0u) ? 1u : 0u; mine = (j == x) ? c : mine; }
        if (sum == G) break;
        __builtin_amdgcn_s_sleep(1);
        if ((++sp & 255u) == 0u) { if (xb_ld(&bar[XB_TMO])) break; if (sp > XB_SPIN_CAP) { atomicAdd(&bar[XB_TMO], 1u); break; } }
    }
    nloc = mine > 0u ? mine : 1u; nx = cnt > 0u ? cnt : 1u;
}

__device__ __forceinline__ void xcd_barrier(const XcdBarrier& b) {
    asm volatile("s_waitcnt vmcnt(0)" ::: "memory");
    __syncthreads();
    if (threadIdx.x == 0) {
        unsigned* bar = b.bar;
        __builtin_amdgcn_s_waitcnt(0);
        unsigned nloc = b.st[0], nx = b.st[1];
        if (nloc == 0u) { xcd_barrier_complete(bar, b.x, nloc, nx); b.st[0] = nloc; b.st[1] = nx; }
        const unsigned old = xb_add(&bar[XB_XSUB(b.x)], 1u);
        const unsigned gen = old / nloc;
        if (old + 1u == (gen + 1u) * nloc) {
            __builtin_amdgcn_fence(__ATOMIC_RELEASE, "agent");
            asm volatile("s_waitcnt vmcnt(0)" ::: "memory");
            const unsigned og = xb_add(&bar[XB_TOP], 1u);
            const unsigned tg = og / nx;
            if (og + 1u == (tg + 1u) * nx) xb_add(&bar[XB_TOPGEN], 1u);
            else XB_SPIN(xb_ld(&bar[XB_TOPGEN]) == tg, bar);
            __builtin_amdgcn_fence(__ATOMIC_ACQUIRE, "agent");
            xb_add(&bar[XB_XGEN(b.x)], 1u);
            asm volatile("s_waitcnt vmcnt(0)" ::: "memory");
        } else {
            XB_SPIN(xb_ld(&bar[XB_XGEN(b.x)]) == gen, bar);
            __builtin_amdgcn_fence(__ATOMIC_ACQUIRE, "agent");
            asm volatile("s_waitcnt vmcnt(0)" ::: "memory");
        }
    }
    __syncthreads();
}

constexpr int NWAVES = 8;
constexpr int NB = 8, NX = 2048, NCX = 256, NR = 2304, MU = NB * NR, DM = 1024, FF = 4096;
constexpr int W_AB = 2304, W_CD = 1536;
constexpr float ALPHA = 1.4142135623730951f, LN_EPS = 1e-6f, RMS_EPS = 1e-6f, LAM_INIT = 0.2f;
constexpr float LOG2E = 1.4426950408889634f;
constexpr size_t MiB = 1u << 20;
constexpr size_t WS_CTL = 0, CTL_ZERO_BYTES = 1 * MiB;
constexpr size_t WS_MODP = 1 * MiB;
constexpr size_t WS_MODV = 5 * MiB;
constexpr size_t WS_XSC = 6 * MiB;
constexpr size_t WS_WIN0 = 14 * MiB;
constexpr size_t WS_WOUT0 = WS_WIN0 + (size_t)2304 * 1024 * 2;
constexpr size_t WS_W10 = WS_WOUT0 + 2 * MiB;
constexpr size_t WS_W20 = WS_W10 + 8 * MiB;
constexpr size_t WS_WQKV1 = WS_W20 + 8 * MiB;
constexpr size_t WS_WFCS = WS_WQKV1 + 3 * MiB;
constexpr size_t WS_WOUT1 = WS_WFCS + 2 * MiB;
constexpr size_t WS_W11 = WS_WOUT1 + 2 * MiB;
constexpr size_t WS_W21 = WS_W11 + 8 * MiB;
constexpr size_t WS_CS = 60 * MiB;
constexpr size_t WS_U = 76 * MiB;
constexpr size_t WS_R = 112 * MiB;
constexpr size_t WS_HX = WS_R;
constexpr size_t WS_OD = WS_R + 81 * MiB;
constexpr size_t WS_HID = WS_R;
constexpr size_t WS_HC = WS_R;
constexpr size_t WS_FCST = WS_R + 54 * MiB;
constexpr size_t WS_END = 256 * MiB;
static_assert(WS_W21 + 8 * MiB <= WS_CS && WS_CS + 16 * MiB == WS_U && WS_U + 36 * MiB == WS_R && WS_OD + 36 * MiB <= WS_END && WS_R + 144 * MiB == WS_END && WS_FCST + 32 * MiB <= WS_END, "d_ws map");
constexpr int CW_TMO = 0, CW_CODE = 1, CW_BAR = 4096;
constexpr int RING_OFF = 0, RING_BYTES = 131072;
constexpr int LDSCTL_OFF = RING_BYTES, MISC_OFF = LDSCTL_OFF + 320;
constexpr int LDS_BYTES = 147456;
constexpr int NA_BIAS_OFF = 86016;

struct Frame { LAS unsigned char* lds; volatile LAS unsigned* MISC; gu32* ctl; int tid, lane, wave, vcu, G; };
struct Args { const float* in[19]; float* out; unsigned char* ws; int ph_lo, ph_hi; };

__device__ __forceinline__ float wave_sum(float v) {
#pragma unroll
    for (int o = 1; o < 64; o <<= 1) v += __shfl_xor(v, o);
    return v;
}
__device__ __forceinline__ float bf2f(unsigned short h) { return __builtin_bit_cast(float, (unsigned)h << 16); }

__device__ __forceinline__ void p0_transpose_item(const float* W, int ldw, int nblk, int K, bf16* WT, int row_off, LAS float* scr, int item, int lane) {
    const int kb = item / nblk, nb = item % nblk, k0 = 64 * kb, n0 = 32 * nb;
#pragma unroll 8
    for (int i = 0; i < 32; ++i) { const int kk = 2 * i + (lane >> 5); scr[kk * 33 + (lane & 31)] = W[(size_t)(k0 + kk) * ldw + n0 + (lane & 31)]; }
    LDS_WAIT(); asm volatile("" ::: "memory");
    const int c = lane & 7;
#pragma unroll
    for (int j = 0; j < 4; ++j) { const int n = (lane >> 3) + 8 * j; const LAS float* s = scr + (8 * c) * 33 + n;
        v4u o; o.x = pk2(s[0 * 33], s[1 * 33]); o.y = pk2(s[2 * 33], s[3 * 33]); o.z = pk2(s[4 * 33], s[5 * 33]); o.w = pk2(s[6 * 33], s[7 * 33]);
        *(GAS v4u*)(WT + (size_t)(row_off + n0 + n) * K + k0 + 8 * c) = o; }
    LDS_WAIT(); asm volatile("" ::: "memory");
}
__device__ __forceinline__ void p0_gemv_item(const float* mod_w, float* MODP, const LAS float* SIL, int item, int lane) {
    const int layer = item / 192, rem = item % 192, cb = rem >> 3, kc = rem & 7, n0 = cb * 256 + 4 * lane;
    f32x4 acc[9];
#pragma unroll
    for (int r = 0; r < 9; ++r) acc[r] = (f32x4){0.f, 0.f, 0.f, 0.f};
    const float* wp = mod_w + ((size_t)layer * 1024 + kc * 128) * 6144 + n0;
    const LAS float* sp = SIL + kc * 128;
#pragma unroll 4
    for (int k = 0; k < 128; ++k) { const f32x4 w = *(const GAS f32x4*)(wp + (size_t)k * 6144);
#pragma unroll
        for (int r = 0; r < 9; ++r) acc[r] += w * sp[r * 1024 + k]; }
#pragma unroll
    for (int r = 0; r < 9; ++r) *(GAS f32x4*)(MODP + ((size_t)((kc * 2 + layer) * 9 + r)) * 6144 + n0) = acc[r];
}
__device__ __forceinline__ void p0_wfcs_item(const float* cdw, bf16* WF, const LAS float* T128, LAS float* scr, int item, int lane) {
    const int kin0 = 4 * item;
#pragma unroll
    for (int q = 0; q < 4; ++q)
#pragma unroll
        for (int jj = 0; jj < 8; ++jj) scr[q * 512 + jj * 64 + lane] = cdw[(size_t)(kin0 + q) * 2048 + 512 + jj * 64 + lane];
    LDS_WAIT(); asm volatile("" ::: "memory");
    for (int g = 0; g < 4; ++g) {
        float a[4][2][2];
#pragma unroll
        for (int q = 0; q < 4; ++q) { a[q][0][0] = 0.f; a[q][0][1] = 0.f; a[q][1][0] = 0.f; a[q][1][1] = 0.f; }
        for (int k = 0; k < 128; ++k) {
            const int m0 = (k * lane) & 127, m1 = m0 ^ ((k & 1) << 6);
            const float c0 = T128[m0], s0 = T128[(m0 + 96) & 127], c1 = T128[m1], s1 = T128[(m1 + 96) & 127];
#pragma unroll
            for (int q = 0; q < 4; ++q) { const float w = scr[q * 512 + g * 128 + k]; a[q][0][0] += w * c0; a[q][1][0] += w * s0; a[q][0][1] += w * c1; a[q][1][1] += w * s1; }
        }
#pragma unroll
        for (int cs = 0; cs < 2; ++cs)
#pragma unroll
            for (int h2 = 0; h2 < 2; ++h2) { const int row = cs * 512 + g * 128 + lane + 64 * h2;
                const unsigned long long v = (unsigned long long)pk2(a[0][cs][h2], a[1][cs][h2]) | ((unsigned long long)pk2(a[2][cs][h2], a[3][cs][h2]) << 32);
                *(GAS unsigned long long*)(WF + (size_t)row * 1024 + kin0) = v; }
    }
    LDS_WAIT(); asm volatile("" ::: "memory");
}
__device__ __forceinline__ void p0_cs_item(bf16* CS, const LAS float* T2048, int tp, int lane) {
#pragma unroll
    for (int jj = 0; jj < 8; ++jj) { const int e0 = jj * 512 + lane * 8, cs = e0 >> 11, t = e0 & 2047; float v[8];
#pragma unroll
        for (int i = 0; i < 8; ++i) { const int m = (tp * (t + i)) & 2047; v[i] = cs ? -T2048[(m + 1536) & 2047] : T2048[m]; }
        v4u o; o.x = pk2(v[0], v[1]); o.y = pk2(v[2], v[3]); o.z = pk2(v[4], v[5]); o.w = pk2(v[6], v[7]);
        *(GAS v4u*)(CS + (size_t)tp * 4096 + e0) = o; }
}
__device__ __forceinline__ void p0_prologue(Frame& F, const Args& A) {
    LAS float* scr = (LAS float*)(F.lds + F.wave * 8448);
    LAS float* SIL = (LAS float*)(F.lds + 67584);
    LAS float* T2048 = (LAS float*)(F.lds + 104448);
    LAS float* T128 = (LAS float*)(F.lds + 112640);
    const float* c = A.in[1]; const float* cctx = A.in[3];
    for (int i = F.tid; i < 9216; i += NWAVES * 64) { const int r = i >> 10, k = i & 1023; const float v = (r < 8) ? c[r * 1024 + k] : cctx[k]; SIL[i] = v / (1.f + expf(-v)); }
    for (int i = F.tid; i < 2048; i += NWAVES * 64) T2048[i] = cospif((float)i * (1.f / 1024.f));
    if (F.tid < 128) T128[F.tid] = cospif((float)F.tid * (1.f / 64.f));
    __syncthreads();
    unsigned char* ws = A.ws;
    float* MODP = (float*)(ws + WS_MODP);
    constexpr int I_GEMV = 384, I_WIN0 = 16 * 72, I_WOUT = 16 * 32, I_W1 = 16 * 128, I_W2 = 64 * 32, I_Q1 = 16 * 16, I_KV1 = 16 * 32, I_FCS = 256, I_CS = 2048;
    constexpr int NITEMS = I_GEMV + I_WIN0 + I_WOUT + I_W1 + I_W2 + I_Q1 + I_KV1 + I_FCS + I_WOUT + I_W1 + I_W2 + I_CS;
    const int gw = F.wave * F.G + F.vcu, NGW = F.G * NWAVES;
    for (int it = gw; it < NITEMS; it += NGW) {
        int r = it;
        if (r < I_GEMV) { p0_gemv_item(A.in[4], MODP, SIL, r, F.lane); continue; } r -= I_GEMV;
        if (r < I_WIN0) { p0_transpose_item(A.in[10], 2304, 72, 1024, (bf16*)(ws + WS_WIN0), 0, scr, r, F.lane); continue; } r -= I_WIN0;
        if (r < I_WOUT) { p0_transpose_item(A.in[11], 1024, 32, 1024, (bf16*)(ws + WS_WOUT0), 0, scr, r, F.lane); continue; } r -= I_WOUT;
        if (r < I_W1) { p0_transpose_item(A.in[8], 4096, 128, 1024, (bf16*)(ws + WS_W10), 0, scr, r, F.lane); continue; } r -= I_W1;
        if (r < I_W2) { p0_transpose_item(A.in[9], 1024, 32, 4096, (bf16*)(ws + WS_W20), 0, scr, r, F.lane); continue; } r -= I_W2;
        if (r < I_Q1) { p0_transpose_item(A.in[16], 2048, 16, 1024, (bf16*)(ws + WS_WQKV1), 0, scr, r, F.lane); continue; } r -= I_Q1;
        if (r < I_KV1) { p0_transpose_item(A.in[16] + 1024, 2048, 32, 1024, (bf16*)(ws + WS_WQKV1), 512, scr, r, F.lane); continue; } r -= I_KV1;
        if (r < I_FCS) { p0_wfcs_item(A.in[16], (bf16*)(ws + WS_WFCS), T128, scr, r, F.lane); continue; } r -= I_FCS;
        if (r < I_WOUT) { p0_transpose_item(A.in[17], 1024, 32, 1024, (bf16*)(ws + WS_WOUT1), 0, scr, r, F.lane); continue; } r -= I_WOUT;
        if (r < I_W1) { p0_transpose_item(A.in[8] + (size_t)1024 * 4096, 4096, 128, 1024, (bf16*)(ws + WS_W11), 0, scr, r, F.lane); continue; } r -= I_W1;
        if (r < I_W2) { p0_transpose_item(A.in[9] + (size_t)4096 * 1024, 1024, 32, 4096, (bf16*)(ws + WS_W21), 0, scr, r, F.lane); continue; } r -= I_W2;
        p0_cs_item((bf16*)(ws + WS_CS), T2048, r, F.lane);
    }
}

__device__ __forceinline__ float modsum(const float* MODP, const float* mod_b, int layer, int row, int n) {
    float s = mod_b[layer * 6144 + n];
#pragma unroll
    for (int kc = 0; kc < 8; ++kc) s += MODP[((size_t)((kc * 2 + layer) * 9 + row)) * 6144 + n];
    return s;
}
__device__ __forceinline__ void p1_mod_u0(Frame& F, const Args& A) {
    unsigned char* ws = A.ws; const float* MODP = (const float*)(ws + WS_MODP); float* MODV = (float*)(ws + WS_MODV); const float* mod_b = A.in[5];
    LAS float* T = (LAS float*)F.lds;
    const int b = F.vcu >> 5, wq = F.vcu & 31;
    for (int i = F.tid; i < 1024; i += NWAVES * 64) {
        T[i] = 1.f + modsum(MODP, mod_b, 0, b, 1024 + i); T[1024 + i] = modsum(MODP, mod_b, 0, b, i);
        T[2048 + i] = 1.f + modsum(MODP, mod_b, 0, 8, 1024 + i); T[3072 + i] = modsum(MODP, mod_b, 0, 8, i); }
    if (F.tid < 432) { const int idx = 432 * F.vcu + F.tid, layer = idx / 55296, rem = idx % 55296, row = rem / 6144, n = rem % 6144; MODV[idx] = modsum(MODP, mod_b, layer, row, n); }
    __syncthreads();
    bf16* U = (bf16*)(ws + WS_U);
    for (int k = 0; k < 9; ++k) {
        const int j = wq * 72 + F.wave * 9 + k; const bool isx = j < 2048;
        const float* src = isx ? A.in[0] + ((size_t)b * 2048 + j) * 1024 : A.in[2] + ((size_t)b * 256 + (j - 2048)) * 1024;
        const LAS float* sc = T + (isx ? 0 : 2048); const LAS float* sh = sc + 1024;
        GAS unsigned long long* o8 = (GAS unsigned long long*)(U + ((size_t)b * 2304 + j) * 1024) + F.lane;
#pragma unroll
        for (int jj = 0; jj < 4; ++jj) { const f32x4 v = *((const GAS f32x4*)src + F.lane + 64 * jj); const f32x4 s = *(const LAS f32x4*)(sc + 4 * F.lane + 256 * jj), h = *(const LAS f32x4*)(sh + 4 * F.lane + 256 * jj);
            const f32x4 u = v * s + h; o8[64 * jj] = (unsigned long long)pk2(u.x, u.y) | ((unsigned long long)pk2(u.z, u.w) << 32); }
    }
}
template <bool WITH_CTX, bool WRITE_U> __device__ __forceinline__ void ph_ln(Frame& F, float* xs_x, float* xs_c, const float* lng, const float* lnb, const float* MODV, int mlayer, int sc_chunk, int sh_chunk, bf16* U) {
    LAS float* T = (LAS float*)F.lds;
    const int b = F.vcu >> 5, wq = F.vcu & 31;
    if (WRITE_U) {
        const float* mx = MODV + ((size_t)(mlayer * 9 + b)) * 6144; const float* mc = MODV + ((size_t)(mlayer * 9 + 8)) * 6144;
        for (int i = F.tid; i < 1024; i += NWAVES * 64) { T[i] = 1.f + mx[sc_chunk * 1024 + i]; T[1024 + i] = mx[sh_chunk * 1024 + i]; T[2048 + i] = 1.f + mc[sc_chunk * 1024 + i]; T[3072 + i] = mc[sh_chunk * 1024 + i]; }
        __syncthreads();
    }
    f32x4 gv[4], bv[4];
#pragma unroll
    for (int jj = 0; jj < 4; ++jj) { gv[jj] = *((const GAS f32x4*)lng + F.lane + 64 * jj); bv[jj] = *((const GAS f32x4*)lnb + F.lane + 64 * jj); }
    constexpr int RPW = WITH_CTX ? 9 : 8;
    for (int k = 0; k < RPW; ++k) {
        const int j = wq * (RPW * 8) + F.wave * RPW + k; const bool isx = j < 2048;
        float* row = isx ? xs_x + ((size_t)b * 2048 + j) * 1024 : xs_c + ((size_t)b * 256 + (j - 2048)) * 1024;
        GAS f32x4* xr = (GAS f32x4*)row + F.lane;
        f32x4 v[4]; float s = 0.f;
#pragma unroll
        for (int jj = 0; jj < 4; ++jj) { v[jj] = xr[64 * jj]; s += (v[jj].x + v[jj].y) + (v[jj].z + v[jj].w); }
        const float mean = wave_sum(s) * (1.f / 1024.f); float s2 = 0.f;
#pragma unroll
        for (int jj = 0; jj < 4; ++jj) { v[jj] = v[jj] - mean; s2 += (v[jj].x * v[jj].x + v[jj].y * v[jj].y) + (v[jj].z * v[jj].z + v[jj].w * v[jj].w); }
        const float rstd = 1.f / sqrtf(wave_sum(s2) * (1.f / 1024.f) + LN_EPS);
        const LAS float* sc = T + (isx ? 0 : 2048); const LAS float* sh = sc + 1024;
        GAS unsigned long long* o8 = (GAS unsigned long long*)(U + ((size_t)b * 2304 + j) * 1024) + F.lane;
#pragma unroll
        for (int jj = 0; jj < 4; ++jj) { const f32x4 y = v[jj] * rstd * gv[jj] + bv[jj]; xr[64 * jj] = y;
            if (WRITE_U) { const f32x4 ss = *(const LAS f32x4*)(sc + 4 * F.lane + 256 * jj), hh = *(const LAS f32x4*)(sh + 4 * F.lane + 256 * jj); const f32x4 u = y * ss + hh;
                o8[64 * jj] = (unsigned long long)pk2(u.x, u.y) | ((unsigned long long)pk2(u.z, u.w) << 32); } }
    }
}
__device__ __forceinline__ void p3_prep(Frame& F, const Args& A) {
    bf16* HX = (bf16*)(A.ws + WS_HX);
    const int b = F.vcu >> 5, wq = F.vcu & 31, l32 = F.lane & 31, d = 2 * l32, axis = l32 >> 4, jf = d & 15;
    const float f0 = exp2f(-(float)jf * (13.287712379549449f / 16.f)), f1 = exp2f(-(float)(jf + 1) * (13.287712379549449f / 16.f));
    const float qw0 = A.in[12][d], qw1 = A.in[12][d + 1], kw0 = A.in[13][d], kw1 = A.in[13][d + 1];
    const float sgn = (l32 & 8) ? 1.f : -1.f;
    const float C2 = 0.125f * LOG2E;
    for (int k = 0; k < 9; ++k) {
        const int j = wq * 72 + F.wave * 9 + k; const bool isx = j < 2048;
        const float p = (float)(axis ? (j & 63) : (j >> 6));
        float c0 = 1.f, s0 = 0.f, c1 = 1.f, s1 = 0.f;
        if (isx) { sincosf(p * f0, &s0, &c0); sincosf(p * f1, &s1, &c1); }
        GAS unsigned* rowp = (GAS unsigned*)(HX + ((size_t)b * 2304 + j) * 2304) + F.lane;
#pragma unroll
        for (int pi = 0; pi < 14; ++pi) {
            if (pi == 9) continue;
            const bool rms = (pi < 4) || (pi == 8), isq = pi < 8;
            const unsigned w = rowp[64 * pi];
            float x0 = bf2f((unsigned short)(w & 0xffffu)), x1 = bf2f((unsigned short)(w >> 16));
            if (rms) { float ss = x0 * x0 + x1 * x1;
#pragma unroll
                for (int o = 1; o < 32; o <<= 1) ss += __shfl_xor(ss, o);
                const float r = 1.f / sqrtf(ss * (1.f / 64.f) + RMS_EPS);
                x0 = x0 * r * (isq ? qw0 : kw0); x1 = x1 * r * (isq ? qw1 : kw1); }
            const float p0 = __shfl_xor(x0, 8), p1 = __shfl_xor(x1, 8);
            float y0 = x0 * c0 + sgn * p0 * s0, y1 = x1 * c1 + sgn * p1 * s1;
            if (isq) { y0 *= C2; y1 *= C2; }
            rowp[64 * pi] = pk2(y0, y1);
        }
    }
}
__device__ __forceinline__ void p5_combine(Frame& F, const Args& A) {
    const bf16* OD = (const bf16*)(A.ws + WS_OD); bf16* O = (bf16*)(A.ws + WS_U);
    const float* lp = A.in[14];
    const float s01 = wave_sum(lp[F.lane] * lp[64 + F.lane]), s23 = wave_sum(lp[128 + F.lane] * lp[192 + F.lane]);
    const float lam = expf(s01) - expf(s23) + LAM_INIT;
    const float w0 = A.in[15][2 * F.lane] * (1.f - LAM_INIT), w1 = A.in[15][2 * F.lane + 1] * (1.f - LAM_INIT);
    for (int k = 0; k < 9; ++k) {
        const size_t m = (size_t)F.vcu * 72 + F.wave * 9 + k;
        const GAS unsigned* src = (const GAS unsigned*)(OD + m * 1024) + F.lane; GAS unsigned* dst = (GAS unsigned*)(O + m * 1024 + 512) + F.lane;
#pragma unroll
        for (int h = 0; h < 4; ++h) { const unsigned a = src[(2 * h) * 64], c = src[(2 * h + 1) * 64];
            const float x0 = bf2f((unsigned short)(a & 0xffffu)) - lam * bf2f((unsigned short)(c & 0xffffu)), x1 = bf2f((unsigned short)(a >> 16)) - lam * bf2f((unsigned short)(c >> 16));
            const float r = 1.f / sqrtf(wave_sum(x0 * x0 + x1 * x1) * (1.f / 128.f) + RMS_EPS);
            dst[h * 64] = pk2(x0 * r * w0, x1 * r * w1); }
    }
}

using abf16 = attn_body::bf16;
__device__ __forceinline__ void p4_attn0(Frame& F, const Args& A, char* lds) {
    const abf16* HX = (const abf16*)(A.ws + WS_HX); abf16* O = (abf16*)(A.ws + WS_U); abf16* OD = (abf16*)(A.ws + WS_OD);
    const int x = F.vcu >> 5, s = F.vcu & 31;
    const abf16* Hb = HX + (size_t)x * 2304 * 2304;
    for (int rr = 0; rr < 7; ++rr) {
        int vh, qb;
        if (rr < 2) { vh = 4 * rr + (s >> 3); qb = s & 7; } else if (rr < 6) { vh = 8 + 4 * (rr - 2) + (s >> 3); qb = s & 7; } else { if (s >= 24) break; vh = s; qb = 8; }
        const abf16 *Q, *K, *V; abf16* Op;
        const size_t qrow = (size_t)x * 2304 + qb * 256;
        if (vh < 8) { const int g = vh >> 2; Q = HX + qrow * 2304 + vh * 64; K = Hb + 1024 + g * 64; V = Hb + 1152 + g * 64; Op = O + qrow * 1024 + vh * 64; }
        else { const int e = vh - 8, h = e >> 2, jj = (e >> 1) & 1, half = e & 1; Q = HX + qrow * 2304 + 512 + (h * 2 + jj) * 64; K = Hb + 1280 + (h * 2 + jj) * 64; V = Hb + 1792 + h * 128 + half * 64; Op = OD + qrow * 1024 + e * 64; }
        attn_body::attn_unit<8, W_AB, 1024, 0>(Q, K, V, Op, (qb < 8) ? 36 : 4, (qb < 8) ? 0 : 2048, 0, 0, nullptr, lds);
    }
}
#ifndef P12_SEL
#define P12_SEL 0
#endif
__device__ __forceinline__ void p12_mixer1(Frame& F, const Args& A, char* lds) {
    const int x = F.vcu >> 5, s = F.vcu & 31;
    if (P12_SEL != 2 && s < 16) {
        pg8::Gemm g{(const pg8::bf16_t*)(A.ws + WS_CS), (const pg8::bf16_t*)(A.ws + WS_FCST), 4096, 32768, 4096};
        pg8::Sched<3> S; S.init(8, 16, 128, x * 16 + s, 4096, 32768);
        pg8::EpiB<3> E{(pg8::bf16_t*)(A.ws + WS_U), 1024, 1.f / 512.f};
        pg8::gemm_phase<pg8::EpiB<3>, pg8::Sched<3>, false, PG8_SP2>(F.lds + RING_OFF, g, S, E);
    } else if (P12_SEL != 1) {
        const abf16* HC = (const abf16*)(A.ws + WS_HC); abf16* O2 = (abf16*)(A.ws + WS_U);
        const abf16* Hb = HC + (size_t)x * 2304 * W_CD;
        LAS float* btab = (LAS float*)(F.lds + NA_BIAS_OFF) + 48;
        const int h = (s - 16) >> 1;
        if (F.tid < 465) btab[F.tid] = A.in[18][h * 465 + F.tid] * LOG2E;
        __syncthreads();
        for (int i = 0; i < 4; ++i) {
            const int idx = 4 * (s - 16) + i, rb = idx & 7, r0 = 4 * rb;
            int first = r0 - 4; first = first < 0 ? 0 : (first > 24 ? 24 : first);
            int last = r0 - 1; last = last < 0 ? 0 : (last > 24 ? 24 : last); last += 7;
            if (((last - first + 1) & 1) != 0) { if (last < 31) ++last; else --first; }
            const int NT = 4 + (last - first + 1);
            const size_t qrow = (size_t)x * 2304 + rb * 256;
            attn_body::attn_unit<8, W_CD, 1024, 1>(HC + qrow * W_CD + h * 64, Hb + 512 + h * 64, Hb + 1024 + h * 64, O2 + qrow * 1024 + h * 64, NT, 0, first, r0, (attn_body::lds_cfptr)btab, lds);
        }
    }
}

constexpr int N_PHASES = 18;
#ifndef MK_PER_PHASE
#define MK_PER_PHASE 1
#endif
__global__ void __launch_bounds__(NWAVES * 64, 2) mega_fwd(Args args) {
    extern __shared__ __attribute__((aligned(16))) unsigned char lds[];
    Frame F;
    F.lds = (LAS unsigned char*)lds;
    F.MISC = (volatile LAS unsigned*)(F.lds + MISC_OFF);
    F.tid = threadIdx.x; F.lane = F.tid & 63; F.wave = __builtin_amdgcn_readfirstlane(F.tid >> 6);
    F.G = gridDim.x; { const int bx = blockIdx.x; F.vcu = (bx % 8) * (F.G / 8) + bx / 8; }
    unsigned char* ws = args.ws;
    F.ctl = (gu32*)(ws + WS_CTL);
    for (int u = F.tid; u < (LDS_BYTES - LDSCTL_OFF) / 4; u += NWAVES * 64) ((LAS unsigned*)(F.lds + LDSCTL_OFF))[u] = 0u;
    __syncthreads();
    XcdBarrier bar; bar.bar = (unsigned*)(F.ctl + CW_BAR); bar.x = 0; bar.st = nullptr;
    if (!MK_PER_PHASE) bar = xcd_barrier_post((unsigned*)(F.ctl + CW_BAR), F.MISC + 8);
    const int lo = args.ph_lo, hi = args.ph_hi;
#ifndef PH_MASK
#define PH_MASK 0x3ffff
#endif
#define IN(k) (((PH_MASK >> (k)) & 1) && lo <= (k) && (k) < hi)
#define SEAM(k) do { if (IN(k) && IN((k) + 1)) xcd_barrier(bar); } while (0)
    typedef pg8::bf16_t pb;
    float* XSX = args.out; float* XSC = (float*)(ws + WS_XSC); const float* MODV = (const float*)(ws + WS_MODV);
    pb* U = (pb*)(ws + WS_U);

    if (IN(0)) { p0_prologue(F, args); } SEAM(0);
    if (IN(1)) { p1_mod_u0(F, args); } SEAM(1);
    if (IN(2)) {
        pg8::Gemm g{U, (const pb*)(ws + WS_WIN0), 1024, 1024, 1024}; pg8::Sched<0> S; S.init(72, 9, F.G, (int)blockIdx.x, 1024, 1024);
        pg8::EpiB<0> E{(pb*)(ws + WS_HX), W_AB, 1.f};
        pg8::gemm_phase<pg8::EpiB<0>, pg8::Sched<0>, PG8_ALIGN, PG8_SP2>(F.lds + RING_OFF, g, S, E);
    } SEAM(2);
    if (IN(3)) { p3_prep(F, args); } SEAM(3);
    if (IN(4)) { p4_attn0(F, args, (char*)lds + RING_OFF); } SEAM(4);
    if (IN(5)) { p5_combine(F, args); } SEAM(5);
    if (IN(6)) {
        pg8::Gemm g{U, (const pb*)(ws + WS_WOUT0), 1024, 1024, 1024}; pg8::Sched<0> S; S.init(72, 4, F.G, (int)blockIdx.x, 1024, 1024);
        pg8::EpiRes E{args.in[0], 2048, args.in[2], 256, XSX, 2048, XSC, 256, MODV + 2 * 1024, ALPHA};
        pg8::gemm_phase<pg8::EpiRes, pg8::Sched<0>, PG8_ALIGN, PG8_SP2>(F.lds + RING_OFF, g, S, E);
    } SEAM(6);
    if (IN(7)) { ph_ln<true, true>(F, XSX, XSC, args.in[6], args.in[7], MODV, 0, 4, 3, (bf16*)U); } SEAM(7);
    if (IN(8)) {
        pg8::Gemm g{U, (const pb*)(ws + WS_W10), 1024, 1024, 1024}; pg8::Sched<0> S; S.init(72, 16, F.G, (int)blockIdx.x, 1024, 1024);
        pg8::EpiB<1> E{(pb*)(ws + WS_HID), FF, 1.f};
        pg8::gemm_phase<pg8::EpiB<1>, pg8::Sched<0>, PG8_ALIGN, PG8_SP2>(F.lds + RING_OFF, g, S, E);
    } SEAM(8);
    if (IN(9)) {
        pg8::Gemm g{(const pb*)(ws + WS_HID), (const pb*)(ws + WS_W20), 4096, 4096, 4096}; pg8::Sched<0> S; S.init(72, 4, F.G, (int)blockIdx.x, 4096, 4096);
        pg8::EpiRes E{XSX, 2048, XSC, 256, XSX, 2048, XSC, 256, MODV + 5 * 1024, ALPHA};
        pg8::gemm_phase<pg8::EpiRes, pg8::Sched<0>, PG8_ALIGN, PG8_SP2>(F.lds + RING_OFF, g, S, E);
    } SEAM(9);
    if (IN(10)) { ph_ln<true, true>(F, XSX, XSC, args.in[6] + 1024, args.in[7] + 1024, MODV, 1, 1, 0, (bf16*)U); } SEAM(10);
    if (IN(11)) {
        { pg8::Gemm g{U, (const pb*)(ws + WS_WQKV1), 1024, 1024, 1024}; pg8::Sched<0> S; S.init(72, 6, F.G, (int)blockIdx.x, 1024, 1024);
          pg8::EpiB<4> E{(pb*)(ws + WS_HC), W_CD, 0.125f * LOG2E};
          pg8::gemm_phase<pg8::EpiB<4>, pg8::Sched<0>, PG8_ALIGN, PG8_SP2>(F.lds + RING_OFF, g, S, E); }
        { pg8::Gemm g{(const pb*)(ws + WS_WFCS), U, 1024, 1024, 1024}; pg8::Sched<2> S; S.init(4, 64, F.G, (int)blockIdx.x, 1024, 1024);
          pg8::EpiB<2> E{(pb*)(ws + WS_FCST), 0, 1.f};
          pg8::gemm_phase<pg8::EpiB<2>, pg8::Sched<2>, PG8_ALIGN, PG8_SP2>(F.lds + RING_OFF, g, S, E); }
    } SEAM(11);
    if (IN(12)) { p12_mixer1(F, args, (char*)lds + RING_OFF); } SEAM(12);
    if (IN(13)) {
        pg8::Gemm g{U, (const pb*)(ws + WS_WOUT1), 1024, 1024, 1024}; pg8::Sched<1> S; S.init(64, 4, F.G, (int)blockIdx.x, 1024, 1024);
        pg8::EpiRes E{XSX, 2048, XSC, 256, XSX, 2048, XSC, 256, MODV + 9 * 6144 + 2 * 1024, ALPHA};
        pg8::gemm_phase<pg8::EpiRes, pg8::Sched<1>, PG8_ALIGN, PG8_SP2>(F.lds + RING_OFF, g, S, E);
    } SEAM(13);
    if (IN(14)) { ph_ln<false, true>(F, XSX, XSC, args.in[6] + 2048, args.in[7] + 2048, MODV, 1, 4, 3, (bf16*)U); } SEAM(14);
    if (IN(15)) {
        pg8::Gemm g{U, (const pb*)(ws + WS_W11), 1024, 1024, 1024}; pg8::Sched<1> S; S.init(64, 16, F.G, (int)blockIdx.x, 1024, 1024);
        pg8::EpiB<1> E{(pb*)(ws + WS_HID), FF, 1.f};
        pg8::gemm_phase<pg8::EpiB<1>, pg8::Sched<1>, PG8_ALIGN, PG8_SP2>(F.lds + RING_OFF, g, S, E);
    } SEAM(15);
    if (IN(16)) {
        pg8::Gemm g{(const pb*)(ws + WS_HID), (const pb*)(ws + WS_W21), 4096, 4096, 4096}; pg8::Sched<1> S; S.init(64, 4, F.G, (int)blockIdx.x, 4096, 4096);
        pg8::EpiRes E{XSX, 2048, XSC, 256, XSX, 2048, XSC, 256, MODV + 9 * 6144 + 5 * 1024, ALPHA};
        pg8::gemm_phase<pg8::EpiRes, pg8::Sched<1>, PG8_ALIGN, PG8_SP2>(F.lds + RING_OFF, g, S, E);
    } SEAM(16);
    if (IN(17)) { ph_ln<false, false>(F, XSX, XSC, args.in[6] + 3072, args.in[7] + 3072, MODV, 0, 0, 0, nullptr); }
#undef IN
#undef SEAM
}

extern "C" void kernel_launch(void* const* d_in, const int* in_sizes, int n_in, void* d_out, int out_size, void* d_ws, size_t ws_size, hipStream_t stream) {
    static int grid = 0;
    if (grid == 0) {
        if (n_in != 19 || in_sizes[0] != NB * NX * DM || out_size != NB * NX * DM || ws_size < WS_END) { fprintf(stderr, "kernel_launch: unexpected shapes (n_in %d, in0 %d, out %d, ws %zu); nothing launched\n", n_in, n_in > 0 ? in_sizes[0] : -1, out_size, ws_size); grid = -1; return; }
        if (hipFuncSetAttribute((const void*)mega_fwd, hipFuncAttributeMaxDynamicSharedMemorySize, LDS_BYTES) != hipSuccess) { fprintf(stderr, "kernel_launch: hipFuncSetAttribute failed\n"); grid = -1; return; }
        int per_cu = 0;
        if (hipOccupancyMaxActiveBlocksPerMultiprocessor(&per_cu, (const void*)mega_fwd, NWAVES * 64, LDS_BYTES) != hipSuccess || per_cu < 1) fprintf(stderr, "kernel_launch: note: occupancy query reports %d workgroups per CU\n", per_cu);
        (void)hipGetLastError();
        grid = 256;
    }
    if (grid < 0) return;
    if (hipMemsetAsync((char*)d_ws + WS_CTL, 0, CTL_ZERO_BYTES, stream) != hipSuccess) { fprintf(stderr, "kernel_launch: hipMemsetAsync failed\n"); return; }
    Args a{};
    for (int i = 0; i < 19; ++i) a.in[i] = (const float*)d_in[i];
    a.out = (float*)d_out; a.ws = (unsigned char*)d_ws;
#if MK_PER_PHASE
    for (int p = 0; p < N_PHASES; ++p) { a.ph_lo = p; a.ph_hi = p + 1; hipLaunchKernelGGL(mega_fwd, dim3(grid), dim3(NWAVES * 64), LDS_BYTES, stream, a); }
#else
    a.ph_lo = 0; a.ph_hi = N_PHASES;
    hipLaunchKernelGGL(mega_fwd, dim3(grid), dim3(NWAVES * 64), LDS_BYTES, stream, a);
#endif
    const hipError_t le = hipPeekAtLastError();
    if (le != hipSuccess) fprintf(stderr, "kernel_launch: launch failed: %s\n", hipGetErrorName(le));
}
```
